# Optimizing an MI355X kernel written in HIP

```python
import jax, jax.numpy as jnp
from jax import lax
import numpy as np

D_MODEL = 1024
BATCH = 4
SEQ = 8192
DEPTH = 2
DEC_BATCH = 1
DEC_SEQ = 16384
PAST_LEN = 128

N_MIXERS = 2
GRID_W = 64
EPS = 1e-6
M_HEADS = 4
M_DQK = 128
M_DV = D_MODEL // M_HEADS
M_CHUNK = 128
M_SPLITS = (M_HEADS * M_DQK, 2 * M_HEADS * M_DQK, 2 * M_HEADS * M_DQK + M_HEADS * M_DV, 2 * M_HEADS * M_DQK + 2 * M_HEADS * M_DV)
M_IN = M_SPLITS[3] + 4 * M_HEADS
F_BIAS = 3.0
A_HEADS = 16
A_KV_HEADS = 4
A_GROUP = A_HEADS // A_KV_HEADS
A_HD = D_MODEL // A_HEADS
A_IN = (A_HEADS + 2 * A_KV_HEADS) * A_HD
Q_BLOCK = 128
ROPE_THETA = 10000.0
ROPE_HALF = A_HD // 2
D_FF = 4 * D_MODEL
N_A = (DEPTH + 1) // 2
N_B = DEPTH // 2

kernel_name = 'hybrid_mlstm_gqa_axial_encoder'


def rmsnorm(x, g):
    xf = x.astype(jnp.float32)
    y = xf * lax.rsqrt(jnp.mean(xf * xf, axis=-1, keepdims=True) + EPS)
    return (y * g.astype(jnp.float32)).astype(x.dtype)


def mlstm_scan(q, k, v, li, lf):
    B, H, L, dqk = q.shape
    dv = v.shape[-1]
    nc = L // M_CHUNK

    def chunks(a):
        return jnp.moveaxis(a.reshape((B, H, nc, M_CHUNK) + a.shape[3:]), 2, 0)

    lower = jnp.tril(jnp.ones((M_CHUNK, M_CHUNK), dtype=bool))

    def step(carry, inp):
        C, n, m = carry
        qc, kc, vc, lic, lfc = inp
        b = jnp.cumsum(lfc, axis=-1)
        dmat = jnp.where(lower, b[..., :, None] - b[..., None, :] + lic[..., None, :], -jnp.inf)
        inter = b + m[..., None]
        m_row = jnp.maximum(inter, jnp.max(dmat, axis=-1))
        w_inter = jnp.exp(inter - m_row)
        p = jnp.exp(dmat - m_row[..., None]) * jnp.einsum('bhjd,bhsd->bhjs', qc, kc)
        num = w_inter[..., None] * jnp.einsum('bhjd,bhde->bhje', qc, C) + jnp.einsum('bhjs,bhse->bhje', p, vc)
        den = w_inter * jnp.einsum('bhjd,bhd->bhj', qc, n) + jnp.sum(p, axis=-1)
        h = num / jnp.maximum(jnp.abs(den), jnp.exp(-m_row))[..., None]
        g = b[..., -1:] - b + lic
        m_new = jnp.maximum(b[..., -1] + m, jnp.max(g, axis=-1))
        decay = jnp.exp(b[..., -1] + m - m_new)
        wk = jnp.exp(g - m_new[..., None])
        C = decay[..., None, None] * C + jnp.einsum('bhsd,bhse->bhde', kc * wk[..., None], vc)
        n = decay[..., None] * n + jnp.einsum('bhs,bhsd->bhd', wk, kc)
        return (C, n, m_new), h

    init = (jnp.zeros((B, H, dqk, dv), jnp.float32), jnp.zeros((B, H, dqk), jnp.float32),
            jnp.full((B, H), -jnp.inf, jnp.float32))
    _, hs = lax.scan(step, init, (chunks(q), chunks(k), chunks(v), chunks(li), chunks(lf)))
    return jnp.moveaxis(hs, 0, 2).reshape(B, H, L, dv)


def mlstm_mixer(h, w_in, b_gate, g_head, w_out):
    B, L, _ = h.shape
    proj = h @ w_in
    q, k, v, o, gates = jnp.split(proj, list(M_SPLITS), axis=-1)

    def heads(a, d):
        return a.reshape(B, L, M_HEADS, d).transpose(0, 2, 1, 3).astype(jnp.float32)

    q = heads(q, M_DQK) * (M_DQK ** -0.5)
    k = heads(k, M_DQK)
    v = heads(v, M_DV)
    gates = (gates.astype(jnp.float32) + b_gate.astype(jnp.float32)).reshape(B, L, 4, M_HEADS).transpose(2, 0, 3, 1)
    li_f, lf_f = gates[0], jax.nn.log_sigmoid(gates[1])
    li_b, lf_b = gates[2], jax.nn.log_sigmoid(gates[3])
    flip = lambda a: jnp.flip(a, axis=2)
    h_fwd = mlstm_scan(q, k, v, li_f, lf_f)
    h_bwd = flip(mlstm_scan(flip(q), flip(k), flip(v), flip(li_b), flip(lf_b)))
    hs = h_fwd + h_bwd
    hs = hs * lax.rsqrt(jnp.mean(hs * hs, axis=-1, keepdims=True) + EPS)
    hs = hs.transpose(0, 2, 1, 3).reshape(B, L, M_HEADS * M_DV) * g_head.astype(jnp.float32)
    y = jax.nn.sigmoid(o.astype(jnp.float32)) * hs
    return y.astype(h.dtype) @ w_out


def rope_tables(pos):
    freqs = ROPE_THETA ** (-jnp.arange(0, ROPE_HALF, 2, dtype=jnp.float32) / ROPE_HALF)
    ang = pos.astype(jnp.float32)[:, None] * freqs[None, :]
    emb = jnp.concatenate([ang, ang], axis=-1)
    return jnp.cos(emb)[:, None, :], jnp.sin(emb)[:, None, :]


def rotate_half(x):
    x1, x2 = jnp.split(x, 2, axis=-1)
    return jnp.concatenate([-x2, x1], axis=-1)


def axial_rope(x, cos_r, sin_r, cos_c, sin_c):
    xf = x.astype(jnp.float32)
    xr, xc = xf[..., :ROPE_HALF], xf[..., ROPE_HALF:]
    out = jnp.concatenate([xr * cos_r + rotate_half(xr) * sin_r,
                           xc * cos_c + rotate_half(xc) * sin_c], axis=-1)
    return out.astype(x.dtype)


def gqa_mixer(h, w_qkv, g_q, g_k, w_o):
    B, L, _ = h.shape
    rows = L // GRID_W
    row_ids = jnp.repeat(jnp.arange(rows), GRID_W)
    col_ids = jnp.arange(rows * GRID_W) % GRID_W
    cos_r, sin_r = rope_tables(row_ids)
    cos_c, sin_c = rope_tables(col_ids)
    proj = h @ w_qkv
    q, k, v = jnp.split(proj, [A_HEADS * A_HD, (A_HEADS + A_KV_HEADS) * A_HD], axis=-1)
    q = q.reshape(B, L, A_HEADS, A_HD)
    k = k.reshape(B, L, A_KV_HEADS, A_HD)
    v = v.reshape(B, L, A_KV_HEADS, A_HD)
    q = axial_rope(rmsnorm(q, g_q), cos_r, sin_r, cos_c, sin_c)
    k = axial_rope(rmsnorm(k, g_k), cos_r, sin_r, cos_c, sin_c)
    nb = L // Q_BLOCK
    qb = q.reshape(B, nb, Q_BLOCK, A_KV_HEADS, A_GROUP, A_HD).transpose(1, 0, 2, 3, 4, 5)
    scale = A_HD ** -0.5

    def attend(qblk):
        s = jnp.einsum('bqhgd,bkhd->bhgqk', qblk, k, preferred_element_type=jnp.float32) * scale
        p = jax.nn.softmax(s, axis=-1)
        return jnp.einsum('bhgqk,bkhd->bqhgd', p.astype(v.dtype), v)

    o = lax.map(attend, qb)
    o = o.transpose(1, 0, 2, 3, 4, 5).reshape(B, L, A_HEADS * A_HD)
    return o @ w_o


def squared_relu_mlp(h, w_up, w_down):
    u = jax.nn.relu(h @ w_up)
    return (u * u) @ w_down


def trunk(x, norm_mix, norm_mlp, a_w_in, a_b_gate, a_g_head, a_w_out,
          b_w_qkv, b_g_q, b_g_k, b_w_o, w_up, w_down):
    for i in range(DEPTH):
        j = i // N_MIXERS
        h = rmsnorm(x, norm_mix[i])
        if i % N_MIXERS == 0:
            x = x + mlstm_mixer(h, a_w_in[j], a_b_gate[j], a_g_head[j], a_w_out[j])
        else:
            x = x + gqa_mixer(h, b_w_qkv[j], b_g_q[j], b_g_k[j], b_w_o[j])
        x = x + squared_relu_mlp(rmsnorm(x, norm_mlp[i]), w_up[i], w_down[i])
    return x


def setup_inputs(seed: int = 0) -> dict:
    key = jax.random.key(seed)
    ks = jax.random.split(key, 14)
    f32 = jnp.float32

    def nrm(k, shape, scale):
        return scale * jax.random.normal(k, shape, f32)

    gate_offset = jnp.repeat(jnp.array([0.0, F_BIAS, 0.0, F_BIAS], f32), M_HEADS)
    return {
        'x_prompt': nrm(ks[0], (BATCH, SEQ, D_MODEL), 1.0),
        'x_sample': nrm(ks[1], (DEC_BATCH, DEC_SEQ, D_MODEL), 1.0),
        'norm_mix': 1.0 + nrm(ks[2], (DEPTH, D_MODEL), 0.02),
        'norm_mlp': 1.0 + nrm(ks[3], (DEPTH, D_MODEL), 0.02),
        'a_w_in': nrm(ks[4], (N_A, D_MODEL, M_IN), D_MODEL ** -0.5),
        'a_b_gate': gate_offset + nrm(ks[5], (N_A, 4 * M_HEADS), 0.1),
        'a_g_head': 1.0 + nrm(ks[6], (N_A, M_HEADS * M_DV), 0.02),
        'a_w_out': nrm(ks[7], (N_A, M_HEADS * M_DV, D_MODEL), (M_HEADS * M_DV) ** -0.5),
        'b_w_qkv': nrm(ks[8], (N_B, D_MODEL, A_IN), D_MODEL ** -0.5),
        'b_g_q': 1.0 + nrm(ks[9], (N_B, A_HD), 0.02),
        'b_g_k': 1.0 + nrm(ks[10], (N_B, A_HD), 0.02),
        'b_w_o': nrm(ks[11], (N_B, A_HEADS * A_HD, D_MODEL), (A_HEADS * A_HD) ** -0.5),
        'w_up': nrm(ks[12], (DEPTH, D_MODEL, D_FF), D_MODEL ** -0.5),
        'w_down': nrm(ks[13], (DEPTH, D_FF, D_MODEL), D_FF ** -0.5),
    }


def reference(x_prompt, x_sample, norm_mix, norm_mlp, a_w_in, a_b_gate, a_g_head, a_w_out,
              b_w_qkv, b_g_q, b_g_k, b_w_o, w_up, w_down):
    y_prompt = trunk(x_prompt, norm_mix, norm_mlp, a_w_in, a_b_gate, a_g_head, a_w_out,
                     b_w_qkv, b_g_q, b_g_k, b_w_o, w_up, w_down)
    y_sample = trunk(x_sample, norm_mix, norm_mlp, a_w_in, a_b_gate, a_g_head, a_w_out,
                     b_w_qkv, b_g_q, b_g_k, b_w_o, w_up, w_down)
    return (y_prompt, y_sample)
```

```cpp
#include <hip/hip_runtime.h>
#include <hip/hip_cooperative_groups.h>
#include <cstdio>
#include <cstdint>
#include <hip/hip_bf16.h>
#include <cmath>
namespace cg = cooperative_groups;
namespace pg8 {
#define PG8_LAS __attribute__((address_space(3)))
typedef unsigned short bf16_t;
typedef short bf16x8 __attribute__((ext_vector_type(8)));
typedef float f32x4 __attribute__((ext_vector_type(4)));
typedef unsigned u32x4 __attribute__((ext_vector_type(4)));
constexpr int BM = 256, BK = 64, HALF = 128, HTB = HALF * BK * 2  , STAGE_BYTES = 8 * HTB, NXCD = 8, WGM = 8;

__host__ __device__ __forceinline__ int lds_byte(int r, int c) { const int st = (r >> 4) * 2 + (c >> 5), rr = r & 15, cc = c & 31, ob = rr * 64 + cc * 2; return st * 1024 + (ob ^ (((ob >> 9) & 1) << 5)); }
__host__ __device__ __forceinline__ void stage_rc(int b, int& R, int& C) { const int st = b / 1024, sb = b % 1024, swz = sb ^ (((sb >> 9) & 1) << 5); R = (st >> 1) * 16 + swz / 64; C = (st & 1) * 32 + (swz % 64) / 2; }
__host__ __device__ __forceinline__ int perm32(int rho) { const int n = rho >> 4, i = rho & 15; return 8 * (i >> 2) + 4 * n + (i & 3); }

struct Unit { int pm, pn; };
struct Gemm { const bf16_t* A; const bf16_t* Bt; int M, N, K, lda; };

struct StaticOrder {
    int nM, nN, nwg, G, c;
    __host__ __device__ void init(int M, int N, int G_, int c_) { nM = M / BM; nN = N / BM; nwg = nM * nN; G = G_; c = c_; }
    __host__ __device__ bool next(int i, Unit& u) const {
        const long L = (long)i * G + c; if (L >= nwg) return false;
        int wgid = (int)L; { const int q = nwg / NXCD, r = nwg % NXCD, xcd = wgid % NXCD, off = wgid / NXCD; wgid = (xcd < r ? xcd * (q + 1) : r * (q + 1) + (xcd - r) * q) + off; }
        const int nig = WGM * nN, gid = wgid / nig, fm = gid * WGM, gsz = (nM - fm) < WGM ? (nM - fm) : WGM;
        u.pm = fm + ((wgid % nig) % gsz); u.pn = (wgid % nig) / gsz; return true;
    }
    __device__ __forceinline__ void a_ready(const Unit&) const {}
    __device__ __forceinline__ void done(const Unit&) const {}
};

__device__ __forceinline__ unsigned cvt_pk_bf16(float lo, float hi) { unsigned r; asm volatile("v_cvt_pk_bf16_f32 %0, %1, %2" : "=v"(r) : "v"(lo), "v"(hi)); return r; }
typedef float f32x2 __attribute__((ext_vector_type(2)));
__device__ __forceinline__ f32x2 gelu_pk(f32x2 v) {
    const f32x2 av = __builtin_elementwise_abs(v), d = av * 0.2316418882f + 1.0f;
    f32x2 t; t.x = __builtin_amdgcn_rcpf(d.x); t.y = __builtin_amdgcn_rcpf(d.y);
    f32x2 q = t * 0.5307027145f + (-0.7265760135f); q = q * t + 0.7107068705f; q = q * t + (-0.142248368f); q = q * t + 0.127414796f; q = q * t;
    const f32x2 s = (v * v) * (-0.72134752044f);
    f32x2 e; e.x = __builtin_amdgcn_exp2f(s.x); e.y = __builtin_amdgcn_exp2f(s.y);
    const f32x2 m = v * (q * e), r = v - m;
    f32x2 o; o.x = v.x < 0.f ? m.x : r.x; o.y = v.y < 0.f ? m.y : r.y; return o;
}

template <int ACT  > struct EpiBf16 {
    static constexpr bool PERM = true, AFTER_DRAIN = false; static_assert(ACT == 0 || ACT == 2, "EpiBf16: ACT is 0 (none) or 2 (squared relu)");
    bf16_t* O; int ldc; const float* bias; int split_cols; size_t split_stride; float scale0; const float* ss;
    __device__ __forceinline__ void operator()(const f32x4 (&acc)[2][2][4][2], const Unit& u, int wr, int wc, int fr, int fq) const {
        const bool lo = fr < 8;
        bf16_t* cbase = O + u.pn * BM + 64 * wc + 8 * fq;
        float rsv[2][4];
#pragma unroll
        for (int ai = 0; ai < 2; ++ai)
#pragma unroll
            for (int m = 0; m < 4; ++m) rsv[ai][m] = ss ? ss[u.pm * BM + wr * 64 + ai * HALF + m * 16 + fr] : 1.0f;
#pragma unroll
        for (int ai = 0; ai < 2; ++ai)
#pragma unroll
            for (int m = 0; m < 4; ++m) rsv[ai][m] = ss ? 1.0f / sqrtf(rsv[ai][m] * (1.0f / 1024.0f) + 1e-6f) : 1.0f;
#pragma unroll
        for (int ai = 0; ai < 2; ++ai)
#pragma unroll
            for (int m = 0; m < 4; ++m) {
                const int rbase = u.pm * BM + wr * 64 + ai * HALF + m * 16;
                const float rs = rsv[ai][m];
                u32x4 w[2];
#pragma unroll
                for (int bj = 0; bj < 2; ++bj) { f32x4 v0 = acc[ai][bj][m][0] * rs, v1 = acc[ai][bj][m][1] * rs;
                    if (ACT == 2) { _Pragma("unroll") for (int q_ = 0; q_ < 4; ++q_) { const float a_ = fmaxf(v0[q_], 0.f), b_ = fmaxf(v1[q_], 0.f); v0[q_] = a_ * a_; v1[q_] = b_ * b_; } }
                    w[bj].x = cvt_pk_bf16(v0[0], v0[1]); w[bj].y = cvt_pk_bf16(v0[2], v0[3]); w[bj].z = cvt_pk_bf16(v1[0], v1[1]); w[bj].w = cvt_pk_bf16(v1[2], v1[3]); }
                u32x4 bx;
#pragma unroll
                for (int k = 0; k < 4; ++k) bx[k] = (unsigned)__builtin_amdgcn_update_dpp(0, (int)w[1][k], 0x128, 0xf, 0xf, false);
                const u32x4 s1 = lo ? w[0] : bx, s2 = lo ? bx : w[0];
                bf16_t* p1 = cbase + (size_t)(rbase + (fr & 7)) * ldc + (lo ? 0 : 32);
                bf16_t* p2 = cbase + (size_t)(rbase + 8 + (fr & 7)) * ldc + (lo ? 32 : 0);
                __builtin_nontemporal_store(s1, (u32x4*)p1); __builtin_nontemporal_store(s2, (u32x4*)p2);
            }
    }
};

template <class Epi, class Sched, bool ALIGN_EPI = false, bool SP2 = false>
__device__ __forceinline__ void gemm_phase(PG8_LAS unsigned char* lds, const Gemm g, const Sched& S, const Epi& E) {
    const int tid = threadIdx.x, wid = __builtin_amdgcn_readfirstlane(tid >> 6), lane = tid & 63, wr = wid >> 2, wc = wid & 3, fr = lane & 15, fq = lane >> 4;
    const int K = g.K, nt = K / BK;
    unsigned voffA[2], voffB[2];
#pragma unroll
    for (int i = 0; i < 2; ++i) { int R, C; stage_rc(tid * 16 + i * 8192, R, C); const int Rb = Epi::PERM ? ((R & ~31) + perm32(R & 31)) : R;
        voffA[i] = (unsigned)(R * g.lda + C) * 2u; voffB[i] = (unsigned)(Rb * K + C) * 2u; }
    const size_t kstep = (size_t)(BK * 2);
    const size_t hstep = (size_t)HALF * K * 2;
    const size_t tstep = 2 * hstep;
    const size_t hstepA = (size_t)HALF * g.lda * 2, tstepA = 2 * hstepA;
    const unsigned ldsw = (unsigned)wid * 1024u;
    const int aoff = lds_byte(wr * 64 + fr, fq * 8), boff = lds_byte(wc * 32 + fr, fq * 8);
#define PG8_SA(b, h) (((b) * 2 + (h)) * HTB)
#define PG8_SB(b, h) ((4 + (b) * 2 + (h)) * HTB)
#define PG8_STAGE(bufoff, gbase, voff) do { _Pragma("unroll") for (int _i = 0; _i < 2; ++_i) \
        __builtin_amdgcn_global_load_lds((const unsigned*)((const char*)(gbase) + (voff)[_i]), (PG8_LAS unsigned*)(lds + (bufoff) + ldsw + _i * 8192), 16, 0, 0); } while (0)
#define PG8_LDA(dst, b, h) do { _Pragma("unroll") for (int m = 0; m < 4; ++m) _Pragma("unroll") for (int k = 0; k < 2; ++k) dst[m][k] = *(const PG8_LAS bf16x8*)(lds + PG8_SA(b, h) + aoff + m * 2048 + k * 1024); } while (0)
#define PG8_LDB(dst, b, h) do { _Pragma("unroll") for (int n = 0; n < 2; ++n) _Pragma("unroll") for (int k = 0; k < 2; ++k) dst[n][k] = *(const PG8_LAS bf16x8*)(lds + PG8_SB(b, h) + boff + n * 2048 + k * 1024); } while (0)
#define PG8_MMA(ai, bj, At, Bt) do { __builtin_amdgcn_s_setprio(1); _Pragma("unroll") for (int m = 0; m < 4; ++m) _Pragma("unroll") for (int n = 0; n < 2; ++n) _Pragma("unroll") for (int k = 0; k < 2; ++k) \
        acc[ai][bj][m][n] = __builtin_amdgcn_mfma_f32_16x16x32_bf16(Bt[n][k], At[m][k], acc[ai][bj][m][n], 0, 0, 0); __builtin_amdgcn_s_setprio(0); } while (0)
#define PG8_WAIT_V(n) asm volatile("s_waitcnt vmcnt(" #n ")" ::: "memory")
#define PG8_WAIT_L(n) asm volatile("s_waitcnt lgkmcnt(" #n ")" ::: "memory")
#define PG8_BAR __builtin_amdgcn_s_barrier()
#define PG8_SCHED __builtin_amdgcn_sched_barrier(0)
    Unit cur, nxt; int ui = 0;
    if (!S.next(0, cur)) return;
    f32x4 acc[2][2][4][2];
#pragma unroll
    for (int a = 0; a < 2; ++a)
#pragma unroll
        for (int b = 0; b < 2; ++b)
#pragma unroll
            for (int m = 0; m < 4; ++m)
#pragma unroll
                for (int n = 0; n < 2; ++n) acc[a][b][m][n] = (f32x4){0.f, 0.f, 0.f, 0.f};
    bf16x8 At[4][2], B0[2][2], B1[2][2];
    const char* cA = (const char*)g.A + (size_t)cur.pm * tstepA; const char* cB = (const char*)g.Bt + (size_t)cur.pn * tstep;
    S.a_ready(cur);
    if constexpr (SP2) {
        PG8_STAGE(PG8_SB(0, 0), cB, voffB); PG8_STAGE(PG8_SB(0, 1), cB + hstep, voffB); PG8_STAGE(PG8_SA(0, 0), cA, voffA); PG8_STAGE(PG8_SA(0, 1), cA + hstepA, voffA);
        if (wr == 1) PG8_BAR;
        PG8_WAIT_V(2); PG8_BAR;
        PG8_STAGE(PG8_SB(1, 0), cB + kstep, voffB); PG8_STAGE(PG8_SA(1, 0), cA + kstep, voffA); PG8_STAGE(PG8_SB(1, 1), cB + hstep + kstep, voffB);
        PG8_WAIT_V(6); PG8_BAR;
    } else {
        PG8_STAGE(PG8_SB(0, 0), cB, voffB); PG8_STAGE(PG8_SA(0, 0), cA, voffA); PG8_STAGE(PG8_SB(0, 1), cB + hstep, voffB); PG8_STAGE(PG8_SA(0, 1), cA + hstepA, voffA);
        if (wr == 1) PG8_BAR;
        PG8_WAIT_V(4); PG8_BAR;
        PG8_STAGE(PG8_SB(1, 0), cB + kstep, voffB); PG8_STAGE(PG8_SA(1, 0), cA + kstep, voffA); PG8_STAGE(PG8_SB(1, 1), cB + hstep + kstep, voffB);
        PG8_WAIT_V(6); PG8_BAR;
    }
    for (;;) {
        const bool has_next = S.next(ui + 1, nxt);
        const char* nA = has_next ? (const char*)g.A + (size_t)nxt.pm * tstepA : cA; const char* nB = has_next ? (const char*)g.Bt + (size_t)nxt.pn * tstep : cB;
        for (int t = 0; t < nt; t += 2) {
            const bool last = (t == nt - 2);
            const char* a1 = cA + (size_t)(t + 1) * kstep;
            const char* a2 = last ? nA : cA + (size_t)(t + 2) * kstep; const char* b2 = last ? nB : cB + (size_t)(t + 2) * kstep;
            const char* a3 = a2 + kstep; const char* b3 = b2 + kstep;
            if (last && has_next) S.a_ready(nxt);
            if constexpr (SP2) {
            PG8_LDB(B0, 0, 0); PG8_LDB(B1, 0, 1); PG8_SCHED; PG8_LDA(At, 0, 0); PG8_STAGE(PG8_SA(1, 1), a1 + hstepA, voffA);
            PG8_WAIT_V(8); PG8_WAIT_L(0); PG8_BAR; PG8_MMA(0, 0, At, B0); PG8_MMA(0, 1, At, B1); PG8_BAR; PG8_SCHED;
            PG8_LDA(At, 0, 1); PG8_STAGE(PG8_SB(0, 0), b2, voffB); PG8_STAGE(PG8_SB(0, 1), b2 + hstep, voffB); PG8_STAGE(PG8_SA(0, 0), a2, voffA);
            PG8_WAIT_V(8); PG8_WAIT_L(0); PG8_BAR; PG8_MMA(1, 0, At, B0); PG8_MMA(1, 1, At, B1); PG8_BAR; PG8_SCHED;
            PG8_LDB(B0, 1, 0); PG8_LDB(B1, 1, 1); PG8_SCHED; PG8_LDA(At, 1, 0); PG8_STAGE(PG8_SA(0, 1), a2 + hstepA, voffA);
            PG8_WAIT_V(8); PG8_WAIT_L(0); PG8_BAR; PG8_MMA(0, 0, At, B0); PG8_MMA(0, 1, At, B1); PG8_BAR; PG8_SCHED;
            PG8_LDA(At, 1, 1); PG8_STAGE(PG8_SB(1, 0), b3, voffB); PG8_STAGE(PG8_SB(1, 1), b3 + hstep, voffB); PG8_STAGE(PG8_SA(1, 0), a3, voffA);
            PG8_WAIT_V(8); PG8_WAIT_L(0); PG8_BAR; PG8_MMA(1, 0, At, B0); PG8_MMA(1, 1, At, B1); PG8_BAR; PG8_SCHED;
            } else {
            PG8_LDB(B0, 0, 0); PG8_SCHED; PG8_LDA(At, 0, 0); PG8_STAGE(PG8_SA(1, 1), a1 + hstepA, voffA);
            PG8_WAIT_L(8); PG8_BAR; PG8_WAIT_L(0); PG8_MMA(0, 0, At, B0); PG8_BAR; PG8_SCHED;
            PG8_LDB(B1, 0, 1); PG8_STAGE(PG8_SB(0, 0), b2, voffB);
            PG8_BAR; PG8_WAIT_L(0); PG8_MMA(0, 1, At, B1); PG8_BAR;
            PG8_LDA(At, 0, 1); PG8_STAGE(PG8_SA(0, 0), a2, voffA);
            PG8_BAR; PG8_WAIT_L(0); PG8_MMA(1, 0, At, B0); PG8_BAR; PG8_SCHED;
            PG8_STAGE(PG8_SB(0, 1), b2 + hstep, voffB);
            PG8_WAIT_V(6); PG8_BAR; PG8_MMA(1, 1, At, B1); PG8_BAR;
            PG8_LDB(B0, 1, 0); PG8_SCHED; PG8_LDA(At, 1, 0); PG8_STAGE(PG8_SA(0, 1), a2 + hstepA, voffA);
            PG8_WAIT_L(8); PG8_BAR; PG8_WAIT_L(0); PG8_MMA(0, 0, At, B0); PG8_BAR; PG8_SCHED;
            PG8_LDB(B1, 1, 1); PG8_STAGE(PG8_SB(1, 0), b3, voffB);
            PG8_BAR; PG8_WAIT_L(0); PG8_MMA(0, 1, At, B1); PG8_BAR;
            PG8_LDA(At, 1, 1); PG8_STAGE(PG8_SA(1, 0), a3, voffA);
            PG8_BAR; PG8_WAIT_L(0); PG8_MMA(1, 0, At, B0); PG8_BAR; PG8_SCHED;
            PG8_STAGE(PG8_SB(1, 1), b3 + hstep, voffB);
            PG8_WAIT_V(6); PG8_BAR; PG8_MMA(1, 1, At, B1); PG8_BAR;
            }
        }
        if constexpr (ALIGN_EPI) { if (wr == 0) PG8_BAR; }
        if constexpr (!Epi::AFTER_DRAIN) { E(acc, cur, wr, wc, fr, fq); S.done(cur); }
        if (!has_next) break;
#pragma unroll
        for (int a = 0; a < 2; ++a)
#pragma unroll
            for (int b = 0; b < 2; ++b)
#pragma unroll
                for (int m = 0; m < 4; ++m)
#pragma unroll
                    for (int n = 0; n < 2; ++n) acc[a][b][m][n] = (f32x4){0.f, 0.f, 0.f, 0.f};
        cur = nxt; cA = nA; cB = nB; ++ui;
        if constexpr (ALIGN_EPI) { if (wr == 1) PG8_BAR; }
    }
    PG8_WAIT_V(0);
    if constexpr (!ALIGN_EPI) { if (wr == 0) PG8_BAR; }
    PG8_BAR;
    if constexpr (Epi::AFTER_DRAIN) { E.fused(acc, cur, wr, wc, fr, fq, lds, wid, lane); S.done(cur); }
#undef PG8_SA
#undef PG8_SB
#undef PG8_STAGE
#undef PG8_LDA
#undef PG8_LDB
#undef PG8_MMA
#undef PG8_WAIT_V
#undef PG8_WAIT_L
#undef PG8_BAR
#undef PG8_SCHED
}
}

#ifndef PG8_SP2
#define PG8_SP2 true
#endif
#ifndef PG8_ALIGN
#define PG8_ALIGN true
#endif
namespace attn_body {
using bf16=__hip_bfloat16;
using bf16x8=__attribute__((ext_vector_type(8)))short;
using s16x4=__attribute__((ext_vector_type(4)))short;
using f32x16=__attribute__((ext_vector_type(16)))float;
using u32x4=__attribute__((ext_vector_type(4)))unsigned;
constexpr int NHEAD=16,D=64,DM=1536,OPITCH=1536,GQ=4;
constexpr int NW=8,QBLK=32,QB=QBLK*NW,KVBLK=64;
constexpr int ATTN_PITCH=DM, ATTN_UNIT_ROWS=QB;
__device__ __forceinline__ int crow(int r,int hi){return (r&3)+8*(r>>2)+4*hi;}
#define SBAR() __builtin_amdgcn_sched_barrier(0)
__device__ __forceinline__ void cmask(f32x16&p0,f32x16&p1,int jb,int qrel,int hi){
  const float NEG=-INFINITY; int kb=64*jb+4*hi;
  #pragma unroll
  for(int r=0;r<16;++r){int kv=kb+(r&3)+8*(r>>2); if(kv>qrel)p0[r]=NEG; if(kv+32>qrel)p1[r]=NEG;}
}

constexpr int NSLOT=3, SLOTB=8192;
constexpr int LDS_K=0, LDS_V=NSLOT*SLOTB, LDS_WS=2*NSLOT*SLOTB, LDS_OST=LDS_WS+NW*64*4, LDS_BYTES=LDS_OST+NW*4096;
constexpr float C2=0.125f*1.4426950408889634f;
__device__ __forceinline__ void glds16(const void*gsrc,unsigned lds_dst){unsigned keep;
  asm volatile("s_mov_b32 %0, m0\n\ts_mov_b32 m0, %2\n\ts_nop 0\n\tglobal_load_lds_dwordx4 %1, off\n\ts_mov_b32 m0, %0":"=&s"(keep):"v"(gsrc),"s"(lds_dst):"memory");}
__device__ __forceinline__ float max3f(float a,float b,float c){float r;asm("v_max3_f32 %0, %1, %2, %3":"=v"(r):"v"(a),"v"(b),"v"(c));return r;}
__device__ __forceinline__ float max2f(float a,float b){float r;asm("v_max_f32_e32 %0, %1, %2":"=v"(r):"v"(a),"v"(b));return r;}
__device__ __forceinline__ float fadd_s(float a,float b){float r;asm("v_add_f32_e32 %0, %1, %2":"=v"(r):"v"(a),"v"(b));return r;}
__device__ __forceinline__ float fsub_s(float a,float b){float r;asm("v_sub_f32_e32 %0, %1, %2":"=v"(r):"v"(a),"v"(b));return r;}
typedef float f32x2_t __attribute__((ext_vector_type(2))); typedef __bf16 bf16x2_t __attribute__((ext_vector_type(2)));
__device__ __forceinline__ unsigned cvtpk_s(float lo,float hi){f32x2_t v={lo,hi};bf16x2_t b=__builtin_convertvector(v,bf16x2_t);return __builtin_bit_cast(unsigned,b);}
#define WAIT_BAR(N) asm volatile("s_waitcnt vmcnt(" #N ") lgkmcnt(0)\n\ts_barrier":::"memory")

__device__ __forceinline__ void qkt(f32x16&p0,f32x16&p1,const char*Kslot,const bf16x8*qr,const f32x16&negm,int r32,int hi){
  const char*kb=Kslot+hi*1024+r32*16;
  #pragma unroll
  for(int d0=0;d0<4;++d0){
    const bf16x8 b0=*reinterpret_cast<const bf16x8*>(kb+d0*2048);
    const bf16x8 b1=*reinterpret_cast<const bf16x8*>(kb+d0*2048+512);
    if(d0==0){p0=__builtin_amdgcn_mfma_f32_32x32x16_bf16(b0,qr[0],negm,0,0,0);p1=__builtin_amdgcn_mfma_f32_32x32x16_bf16(b1,qr[0],negm,0,0,0);}
    else{p0=__builtin_amdgcn_mfma_f32_32x32x16_bf16(b0,qr[d0],p0,0,0,0);p1=__builtin_amdgcn_mfma_f32_32x32x16_bf16(b1,qr[d0],p1,0,0,0);}}
}
typedef __attribute__((address_space(3))) const char* lds_cptr;
typedef short v4i16_t __attribute__((ext_vector_type(4)));
__device__ __forceinline__ void kload8(bf16x8*kf,lds_cptr kp){
  kf[0]=*(const __attribute__((address_space(3))) bf16x8*)(kp);      kf[1]=*(const __attribute__((address_space(3))) bf16x8*)(kp+512);
  kf[2]=*(const __attribute__((address_space(3))) bf16x8*)(kp+2048); kf[3]=*(const __attribute__((address_space(3))) bf16x8*)(kp+2560);
  kf[4]=*(const __attribute__((address_space(3))) bf16x8*)(kp+4096); kf[5]=*(const __attribute__((address_space(3))) bf16x8*)(kp+4608);
  kf[6]=*(const __attribute__((address_space(3))) bf16x8*)(kp+6144); kf[7]=*(const __attribute__((address_space(3))) bf16x8*)(kp+6656);
}
__device__ __forceinline__ void kload2(bf16x8*kf,lds_cptr kp,int j){ kf[2*j]=*(const __attribute__((address_space(3))) bf16x8*)(kp+j*2048); kf[2*j+1]=*(const __attribute__((address_space(3))) bf16x8*)(kp+j*2048+512); }
__device__ __forceinline__ s16x4 vtr(lds_cptr p){ return __builtin_bit_cast(s16x4,__builtin_amdgcn_ds_read_tr16_b64_v4i16((__attribute__((address_space(3))) v4i16_t*)p)); }
__device__ __forceinline__ float rowmax(const f32x16&p0,const f32x16&p1){
  float a=max3f(p0[0],p0[1],p1[0]),b=max3f(p0[2],p0[3],p1[1]);a=max3f(a,p1[2],p1[3]);
  #pragma unroll
  for(int r=4;r<16;r+=4){a=max3f(a,p0[r],p0[r+1]);b=max3f(b,p0[r+2],p0[r+3]);a=max3f(a,p1[r],p1[r+1]);b=max3f(b,p1[r+2],p1[r+3]);}
  const float m=max2f(a,b);
  auto rr=__builtin_amdgcn_permlane32_swap(__float_as_uint(m),__float_as_uint(m),false,false);
  return max2f(__uint_as_float(rr[0]),__uint_as_float(rr[1]));
}
__device__ __forceinline__ void pv(f32x16*o,int vb,bf16x8 pa0,bf16x8 pa1,bf16x8 pa2,bf16x8 pa3){
  #pragma unroll
  for(int d0=0;d0<2;++d0){s16x4 lo[4],hi[4];
    #pragma unroll
    for(int ks=0;ks<4;++ks){
      asm volatile("ds_read_b64_tr_b16 %0,%1 offset:%c2":"=&v"(lo[ks]):"v"(vb),"i"(d0*4096+ks*1024):"memory");
      asm volatile("ds_read_b64_tr_b16 %0,%1 offset:%c2":"=&v"(hi[ks]):"v"(vb),"i"(d0*4096+ks*1024+512):"memory");}
    asm volatile("s_waitcnt lgkmcnt(0)":::"memory");SBAR();
    #define PK(k) (bf16x8){lo[k][0],lo[k][1],lo[k][2],lo[k][3],hi[k][0],hi[k][1],hi[k][2],hi[k][3]}
    o[d0]=__builtin_amdgcn_mfma_f32_32x32x16_bf16(pa0,PK(0),o[d0],0,0,0);
    o[d0]=__builtin_amdgcn_mfma_f32_32x32x16_bf16(pa1,PK(1),o[d0],0,0,0);
    o[d0]=__builtin_amdgcn_mfma_f32_32x32x16_bf16(pa2,PK(2),o[d0],0,0,0);
    o[d0]=__builtin_amdgcn_mfma_f32_32x32x16_bf16(pa3,PK(3),o[d0],0,0,0);
    #undef PK
  }
}

#ifndef ATTN_STORE16
#define ATTN_STORE16(p,v) (*(u32x4*)(p)=(v))
#endif
template<int THRL> __device__ __forceinline__ void attn_unit(const float mref,long rowbase,int SEQ,int h,int qb,const bf16*Q,const bf16*__restrict__ K,const bf16*__restrict__ V,bf16*O,char*shm){
  const int tid=threadIdx.x,lane=tid&63,r32=lane&31,hi=lane>>5; const int wid=__builtin_amdgcn_readfirstlane(tid>>6);
  const int q0=qb*QB;
  const bf16*Qw=Q+(rowbase+q0+wid*QBLK)*DM+h*D;
  const bf16*Kh=K+rowbase*DM+(h/GQ)*D,*Vh=V+rowbase*DM+(h/GQ)*D;
  const unsigned lds0=(unsigned)(uintptr_t)shm;
  float*wsf=(float*)(shm+LDS_WS)+wid*64;
  const bf16*ksrc=Kh+(long)lane*DM+wid*8;
  const bf16*vsrc=Vh+(long)(16*(wid&3)+(lane>>2))*DM+(wid>>2)*32+(lane&3)*8;
  const unsigned kdst=lds0+LDS_K+wid*1024, vdst=lds0+LDS_V+wid*1024;
  #define DMA_K(t,slot) glds16(ksrc+(long)(t)*KVBLK*DM,(unsigned)__builtin_amdgcn_readfirstlane(kdst+(slot)))
  #define DMA_V(t,slot) glds16(vsrc+(long)(t)*KVBLK*DM,(unsigned)__builtin_amdgcn_readfirstlane(vdst+(slot)))
  const int vb0=(int)(lds0+LDS_V)+((lane>>4)&1)*32+(lane&3)*8+(4*hi+((lane&15)>>2))*64;
  const char*Kbase=shm+LDS_K; bf16x8 kf[8];
  const lds_cptr shm3=(lds_cptr)shm; const lds_cptr kp0=shm3+LDS_K+hi*1024+r32*16; const lds_cptr vp0=shm3+LDS_V+((lane>>4)&1)*32+(lane&3)*8+(4*hi+((lane&15)>>2))*64;
  if(wid<4)__builtin_amdgcn_s_setprio(1);
  const int NT=SEQ/KVBLK;
  DMA_K(0,0);DMA_V(0,0);DMA_K(1,SLOTB);
  bf16x8 qr[4];
  #pragma unroll
  for(int d0=0;d0<4;++d0)qr[d0]=*reinterpret_cast<const bf16x8*>(&Qw[(long)r32*DM+d0*16+hi*8]);
  float mhat=0.f,l_reg=0.f;f32x16 o[2];o[0]=f32x16{};o[1]=f32x16{};f32x16 negm=f32x16{};asm volatile("":"+v"(negm));

  #define CMASK(P0,P1,t) do{}while(0)
  bool resc=false;
  #define START(P0,P1) do{ const float rm=mref; resc=false; \
    { const float dl=rm; mhat=fadd_s(mhat,dl); \
      _Pragma("unroll") for(int r=0;r<16;++r){P0[r]=fsub_s(P0[r],dl);P1[r]=fsub_s(P1[r],dl);} \
      _Pragma("unroll") for(int r=0;r<16;++r)negm[r]=-mhat; asm volatile("":"+v"(negm)); } \
    _Pragma("unroll") for(int r=0;r<16;++r)P0[r]=__builtin_amdgcn_exp2f(P0[r]); }while(0)
  #define RESC() do{ if(resc){ asm volatile("s_waitcnt lgkmcnt(0)":::"memory"); \
      _Pragma("unroll") for(int d_=0;d_<2;++d_) _Pragma("unroll") for(int r=0;r<16;++r)o[d_][r]*=wsf[crow(r,hi)]; } }while(0)
  f32x16 pA0,pA1,pB0,pB1;
  int sl_prev=0,sl_cur=0,sl_next=SLOTB;
  #define ROT() do{sl_prev=sl_cur;sl_cur=sl_next;sl_next=(sl_next==(NSLOT-1)*SLOTB)?0:sl_next+SLOTB;}while(0)
  DMA_K(2,2*SLOTB);
  WAIT_BAR(3);
  qkt(pA0,pA1,Kbase,qr,negm,r32,hi);asm volatile("s_nop 15\n\ts_nop 7":"+v"(pA0),"+v"(pA1));CMASK(pA0,pA1,0);
  START(pA0,pA1);
  _Pragma("unroll") for(int r=0;r<16;++r)pA1[r]=__builtin_amdgcn_exp2f(pA1[r]);
  WAIT_BAR(0);
  DMA_K(3,0);DMA_V(1,SLOTB);
  ROT();
  kload8(kf,kp0+sl_cur);
  WAIT_BAR(2);
  s16x4 vlo[8],vhi[8]; u32x4 pw0,pw1,pw2,pw3;
  #define PKW(P,B) cvtpk_s(P[B],P[B+1])
  #define PAF(k) __builtin_bit_cast(bf16x8,pw##k)
  #define VFR(i) (bf16x8){vlo[i][0],vlo[i][1],vlo[i][2],vlo[i][3],vhi[i][0],vhi[i][1],vhi[i][2],vhi[i][3]}
  #define PIN(x) asm volatile("":"+v"(x))
  #define MX3(a,b,c) __builtin_fmaxf(__builtin_fmaxf((a),(b)),(c))
  #define GAPA(MF,A0,A1,A2,A3,W0,W1,PW) do{ MF; sacc+=A0; sacc+=A1; sacc+=A2; sacc+=A3; PIN(sacc); W0; W1; PIN(PW); SBAR(); }while(0)
  #define EX(v) __builtin_amdgcn_exp2f(v)
  #define GAPB(MF,X,B) do{ MF; X[B]=EX(X[B]); X[B+1]=EX(X[B+1]); X[B+2]=EX(X[B+2]); X[B+3]=EX(X[B+3]); PIN(X); SBAR(); }while(0)
  #define VRD(i) do{ vlo[i]=vtr(vp_+(((i)>>2)*4096+((i)&3)*1024)); vhi[i]=vtr(vp_+(((i)>>2)*4096+((i)&3)*1024+512)); }while(0)
  #define KRD(G,j) do{ if(G){ kload2(kf,kp0+sl_next,j); SBAR(); } }while(0)
  #define STEP(C0,C1,P0,P1,t,GK,GV,GL) do{ SBAR(); \
    const lds_cptr vp_=vp0+sl_prev; \
    VRD(0); SBAR(); float sacc=(P0[0]+P0[1]); \
    GAPA(C0=__builtin_amdgcn_mfma_f32_32x32x16_bf16(kf[0],qr[0],negm,0,0,0), P0[2],P0[3],P0[4],P0[5],     pw0[0]=PKW(P0,0), pw0[1]=PKW(P0,2), pw0); \
    VRD(4); SBAR(); GAPA(C1=__builtin_amdgcn_mfma_f32_32x32x16_bf16(kf[1],qr[0],negm,0,0,0), P0[6],P0[7],P0[8],P0[9],     pw0[2]=PKW(P0,4), pw0[3]=PKW(P0,6), pw0); \
    VRD(1); SBAR(); GAPA(C0=__builtin_amdgcn_mfma_f32_32x32x16_bf16(kf[2],qr[1],C0,0,0,0),   P0[10],P0[11],P0[12],P0[13], pw1[0]=PKW(P0,8), pw1[1]=PKW(P0,10), pw1); \
    VRD(5); SBAR(); GAPA(C1=__builtin_amdgcn_mfma_f32_32x32x16_bf16(kf[3],qr[1],C1,0,0,0),   P0[14],P0[15],P1[0],P1[1],   pw1[2]=PKW(P0,12),pw1[3]=PKW(P0,14), pw1); \
    VRD(2); SBAR(); GAPA(C0=__builtin_amdgcn_mfma_f32_32x32x16_bf16(kf[4],qr[2],C0,0,0,0),   P1[2],P1[3],P1[4],P1[5],     pw2[0]=PKW(P1,0), pw2[1]=PKW(P1,2), pw2); \
    VRD(6); SBAR(); GAPA(C1=__builtin_amdgcn_mfma_f32_32x32x16_bf16(kf[5],qr[2],C1,0,0,0),   P1[6],P1[7],P1[8],P1[9],     pw2[2]=PKW(P1,4), pw2[3]=PKW(P1,6), pw2); \
    VRD(3); SBAR(); GAPA(C0=__builtin_amdgcn_mfma_f32_32x32x16_bf16(kf[6],qr[3],C0,0,0,0),   P1[10],P1[11],P1[12],P1[13], pw3[0]=PKW(P1,8), pw3[1]=PKW(P1,10), pw3); \
    VRD(7); SBAR(); GAPA(C1=__builtin_amdgcn_mfma_f32_32x32x16_bf16(kf[7],qr[3],C1,0,0,0),   P1[14],P1[15],0.f,0.f,       pw3[2]=PKW(P1,12),pw3[3]=PKW(P1,14), pw3); \
    l_reg+=sacc; \
    if(GK){DMA_K((t)+3,sl_cur);} if(GV){DMA_V((t)+1,sl_next);} \
    CMASK(C0,C1,t); \
    resc=false;   \
    SBAR(); \
    GAPB(o[0]=__builtin_amdgcn_mfma_f32_32x32x16_bf16(PAF(0),VFR(0),o[0],0,0,0), C0,0); \
    GAPB(o[1]=__builtin_amdgcn_mfma_f32_32x32x16_bf16(PAF(0),VFR(4),o[1],0,0,0), C0,4); \
    KRD(GL,0); GAPB(o[0]=__builtin_amdgcn_mfma_f32_32x32x16_bf16(PAF(1),VFR(1),o[0],0,0,0), C0,8); \
    KRD(GL,1); GAPB(o[1]=__builtin_amdgcn_mfma_f32_32x32x16_bf16(PAF(1),VFR(5),o[1],0,0,0), C0,12); \
    KRD(GL,2); GAPB(o[0]=__builtin_amdgcn_mfma_f32_32x32x16_bf16(PAF(2),VFR(2),o[0],0,0,0), C1,0); \
    KRD(GL,3); GAPB(o[1]=__builtin_amdgcn_mfma_f32_32x32x16_bf16(PAF(2),VFR(6),o[1],0,0,0), C1,4); \
    GAPB(o[0]=__builtin_amdgcn_mfma_f32_32x32x16_bf16(PAF(3),VFR(3),o[0],0,0,0), C1,8); \
    GAPB(o[1]=__builtin_amdgcn_mfma_f32_32x32x16_bf16(PAF(3),VFR(7),o[1],0,0,0), C1,12); \
    }while(0)
  int t=1;
  #undef CMASK
  #define CMASK(P0,P1,t) do{}while(0)
  for(;t+5<NT;t+=2){
    STEP(pB0,pB1,pA0,pA1,t,true,true,true);     WAIT_BAR(2); RESC(); ROT();
    STEP(pA0,pA1,pB0,pB1,t+1,true,true,true);   WAIT_BAR(2); RESC(); ROT();
  }
  #undef CMASK
  #define CMASK(P0,P1,t) do{}while(0)
  #define ENDW(tt) do{ if((tt)+3<NT){WAIT_BAR(2);} else if((tt)+2<NT){WAIT_BAR(1);} else {WAIT_BAR(0);} }while(0)
  for(;t+1<NT;t+=2){
    STEP(pB0,pB1,pA0,pA1,t,(t+3<NT),(t+1<NT),(t+1<NT));       ENDW(t);   RESC(); ROT();
    STEP(pA0,pA1,pB0,pB1,t+1,(t+4<NT),(t+2<NT),(t+2<NT));     ENDW(t+1); RESC(); ROT();
  }
  STEP(pB0,pB1,pA0,pA1,NT-1,false,false,false); RESC();
  { float sacc=pB0[0]+pB0[1]; _Pragma("unroll") for(int r=2;r<16;++r)sacc+=pB0[r]; _Pragma("unroll") for(int r=0;r<16;++r)sacc+=pB1[r]; l_reg+=sacc;
    pw0=(u32x4){PKW(pB0,0),PKW(pB0,2),PKW(pB0,4),PKW(pB0,6)};pw1=(u32x4){PKW(pB0,8),PKW(pB0,10),PKW(pB0,12),PKW(pB0,14)};pw2=(u32x4){PKW(pB1,0),PKW(pB1,2),PKW(pB1,4),PKW(pB1,6)};pw3=(u32x4){PKW(pB1,8),PKW(pB1,10),PKW(pB1,12),PKW(pB1,14)};
    SBAR(); pv(o,vb0+sl_cur,PAF(0),PAF(1),PAF(2),PAF(3)); }
  #undef PKW
  #undef PAF
  #undef VFR
  #undef PIN
  #undef MX3
  #undef GAPA
  #undef GAPB
  #undef EX
  #undef VRD
  #undef KRD
  #undef STEP
  #undef ENDW
  {auto rr=__builtin_amdgcn_permlane32_swap(__float_as_uint(l_reg),__float_as_uint(l_reg),false,false);l_reg=__uint_as_float(rr[0])+__uint_as_float(rr[1]);}
  if(hi==0)wsf[32+r32]=l_reg;asm volatile("s_waitcnt lgkmcnt(0)":::"memory");
  float rli[16];
  #pragma unroll
  for(int r=0;r<16;++r)rli[r]=__builtin_amdgcn_rcpf(wsf[32+crow(r,hi)]);
  bf16*Ow=O+(rowbase+q0+wid*QBLK)*OPITCH+h*D;
  { bf16*stg=(bf16*)(shm+LDS_OST)+wid*2048;
    #pragma unroll
    for(int r=0;r<16;++r){const int orow=crow(r,hi);
      #pragma unroll
      for(int d0=0;d0<2;++d0)stg[orow*64+d0*32+r32]=__float2bfloat16(o[d0][r]*rli[r]);}
    asm volatile("s_waitcnt lgkmcnt(0)":::"memory");
    #pragma unroll
    for(int i=0;i<4;++i){const int row=i*8+(lane>>3),ch=lane&7; const u32x4 v=*(const u32x4*)(stg+row*64+ch*8); ATTN_STORE16(Ow+(long)row*OPITCH+ch*8,v);} }
  __builtin_amdgcn_s_setprio(0);
  asm volatile("s_waitcnt lgkmcnt(0)\n\ts_barrier":::"memory");
  #undef DMA_K
  #undef DMA_V
  #undef CMASK
  #undef START
  #undef RESC
  #undef ROT
}
constexpr int ATTN_LDS_BYTES=LDS_BYTES;
#undef SBAR
#undef WAIT_BAR
}
#define GAS __attribute__((address_space(1)))
#define LAS __attribute__((address_space(3)))
typedef unsigned short bf16;
typedef unsigned v4u __attribute__((ext_vector_type(4)));
typedef unsigned v2u __attribute__((ext_vector_type(2)));
typedef float f32x4 __attribute__((ext_vector_type(4)));
typedef short bf16x8 __attribute__((ext_vector_type(8)));
typedef short s16x4 __attribute__((ext_vector_type(4)));

#ifndef MK_N_LAUNCHES
#define MK_N_LAUNCHES 1
#endif
constexpr int NWAVES = 8;
enum Phase { PH_PRE0 = 0, PH_INPROJ, PH_MA, PH_MB, PH_GATE, PH_OUTPROJ, PH_UP0, PH_DOWN0, PH_QKV, PH_ATTN, PH_OPROJ, PH_UP1, PH_DOWN1, NPHASE };
constexpr int T_TOK = 49152, NPROMPT = 32768, DMOD = 1024, FF = 4096;
constexpr int N_IN = 3088, N_IN_PAD = 3328, NQKV = 1536;
constexpr float EPS = 1e-6f;
constexpr size_t MiB = 1u << 20;
constexpr size_t WS_WA = 1 * MiB, WS_WB = 8 * MiB, WS_WU = 10 * MiB, WS_WD = 18 * MiB, WS_XN = 26 * MiB, WS_BIG = 122 * MiB, WS_ST = 440 * MiB, WS_W2A = 506 * MiB, WS_W2B = 509 * MiB, WS_END = 511 * MiB;
constexpr size_t WS_SS = 65536, WS_TAB = 868352  , CTL_ZERO_BYTES = 1 * MiB;
constexpr int LDS_BYTES = 159744;

__device__ __forceinline__ unsigned f2bf(float f) { unsigned u = __builtin_bit_cast(unsigned, f); return (u + 0x7fffu + ((u >> 16) & 1u)) >> 16; }
typedef float f32x2v_t __attribute__((ext_vector_type(2))); typedef __bf16 bf16x2v_t __attribute__((ext_vector_type(2)));
__device__ __forceinline__ unsigned pk2(float lo, float hi) { f32x2v_t v = {lo, hi}; bf16x2v_t b = __builtin_convertvector(v, bf16x2v_t); return __builtin_bit_cast(unsigned, b); }
__device__ __forceinline__ float bflo(unsigned u) { return __uint_as_float(u << 16); }
__device__ __forceinline__ float bfhi(unsigned u) { return __uint_as_float(u & 0xffff0000u); }
__device__ __forceinline__ float bf1(unsigned short u) { return __uint_as_float(((unsigned)u) << 16); }
__device__ __forceinline__ float wave_sum(float v) {
#pragma unroll
    for (int o = 1; o < 64; o <<= 1) v += __shfl_xor(v, o);
    return v;
}
__device__ __forceinline__ float fexp(float x) { return __builtin_amdgcn_exp2f(x * 1.4426950408889634f); }
__device__ __forceinline__ float flog(float x) { return __builtin_amdgcn_logf(x) * 0.6931471805599453f; }
#define LDS_WAIT() asm volatile("s_waitcnt lgkmcnt(0)" ::: "memory")

template <int MODE> struct EpiRes {
    static constexpr bool PERM = true, AFTER_DRAIN = false;
    const float* base0; const float* base1; int split_row; float* out; int ldc; bf16* xb; float* ss;
    __device__ __forceinline__ void operator()(const pg8::f32x4 (&acc)[2][2][4][2], const pg8::Unit& u, int wr, int wc, int fr, int fq) const {
#pragma unroll
        for (int ai = 0; ai < 2; ++ai) {
            v4u bw[4][2]; f32x4 bf0[4][2], bf1[4][2]; float r2v[4];
#pragma unroll
            for (int m = 0; m < 4; ++m) {
                const int row = u.pm * 256 + ai * 128 + wr * 64 + m * 16 + fr;
                r2v[m] = ((MODE == 1 || MODE == 2) && base1) ? base1[row] : 1.0f;
#pragma unroll
                for (int bj = 0; bj < 2; ++bj) { const int col = u.pn * 256 + bj * 128 + wc * 32 + 8 * fq;
                    if (MODE == 0) { const float* b = (row < split_row) ? base0 + (size_t)row * ldc : base1 + (size_t)(row - split_row) * ldc; bf0[m][bj] = *(const f32x4*)(b + col); bf1[m][bj] = *(const f32x4*)(b + col + 4); }
                    else bw[m][bj] = *(const v4u*)(xb + (size_t)row * ldc + col); }
            }
#pragma unroll
            for (int m = 0; m < 4; ++m) {
                const int row = u.pm * 256 + ai * 128 + wr * 64 + m * 16 + fr;
                float sq = 0.f;
                const float r2 = ((MODE == 1 || MODE == 2) && base1) ? 1.0f / (r2v[m] * (1.0f / 1024.0f) + 1e-6f) : 1.0f;
#pragma unroll
                for (int bj = 0; bj < 2; ++bj) {
                    const int col = u.pn * 256 + bj * 128 + wc * 32 + 8 * fq;
                    f32x4 v0, v1;
                    if (MODE == 0) { v0 = bf0[m][bj]; v1 = bf1[m][bj]; }
                    else { const v4u w_ = bw[m][bj]; v0 = (f32x4){bflo(w_.x), bfhi(w_.x), bflo(w_.y), bfhi(w_.y)}; v1 = (f32x4){bflo(w_.z), bfhi(w_.z), bflo(w_.w), bfhi(w_.w)}; }
                    v0 = v0 + acc[ai][bj][m][0] * r2; v1 = v1 + acc[ai][bj][m][1] * r2;
                    if (MODE == 2) { float* o = out + (size_t)row * ldc + col; __builtin_nontemporal_store(v0, (f32x4*)o); __builtin_nontemporal_store(v1, (f32x4*)(o + 4)); }
                    else {
                        v4u w; w.x = pk2(v0[0], v0[1]); w.y = pk2(v0[2], v0[3]); w.z = pk2(v1[0], v1[1]); w.w = pk2(v1[2], v1[3]);
                        *(v4u*)(xb + (size_t)row * ldc + col) = w;
                        sq += (v0[0] * v0[0] + v0[1] * v0[1]) + (v0[2] * v0[2] + v0[3] * v0[3]) + (v1[0] * v1[0] + v1[1] * v1[1]) + (v1[2] * v1[2] + v1[3] * v1[3]);
                    }
                }
                if (MODE != 2) { sq += __shfl_xor(sq, 16); sq += __shfl_xor(sq, 32); if (fq == 0) atomicAdd(ss + row, sq); }
            }
        }
    }
};

struct EpiQKV {
    static constexpr bool PERM = true, AFTER_DRAIN = false;
    bf16* O; const float* ss; const float* gq; const float* gk; const float* tab;
    __device__ __forceinline__ void operator()(const pg8::f32x4 (&acc)[2][2][4][2], const pg8::Unit& u, int wr, int wc, int fr, int fq) const {
        const int pn = u.pn; const bool rot = pn < 5;
        const float* g = (pn < 4) ? gq : gk;
        f32x4 gg[2][2];
#pragma unroll
        for (int bj = 0; bj < 2; ++bj)
#pragma unroll
            for (int n = 0; n < 2; ++n) gg[bj][n] = *(const f32x4*)(g + 32 * bj + 8 * fq + 4 * n);
        const float osc = (pn < 4) ? attn_body::C2 : 1.f, sgn = (fq & 2) ? 1.f : -1.f;
        const int fo = 8 * (fq & 1);
        float rsv[2][4];
#pragma unroll
        for (int ai = 0; ai < 2; ++ai)
#pragma unroll
            for (int m = 0; m < 4; ++m) rsv[ai][m] = ss[u.pm * 256 + ai * 128 + wr * 64 + m * 16 + fr];
#pragma unroll
        for (int ai = 0; ai < 2; ++ai)
#pragma unroll
            for (int m = 0; m < 4; ++m) {
                const int row = u.pm * 256 + ai * 128 + wr * 64 + m * 16 + fr;
                const float rs = 1.0f / sqrtf(rsv[ai][m] * (1.0f / 1024.0f) + 1e-6f);
                f32x4 x[2][2];
#pragma unroll
                for (int bj = 0; bj < 2; ++bj)
#pragma unroll
                    for (int n = 0; n < 2; ++n) x[bj][n] = acc[ai][bj][m][n] * rs;
                if (rot) {
                    float s = 0.f;
#pragma unroll
                    for (int bj = 0; bj < 2; ++bj)
#pragma unroll
                        for (int n = 0; n < 2; ++n) s += (x[bj][n][0] * x[bj][n][0] + x[bj][n][1] * x[bj][n][1]) + (x[bj][n][2] * x[bj][n][2] + x[bj][n][3] * x[bj][n][3]);
                    s += __shfl_xor(s, 16); s += __shfl_xor(s, 32);
                    const float rh = 1.0f / sqrtf(s * (1.0f / 64.0f) + 1e-6f);
                    const int pos = (row < NPROMPT) ? (row & 8191) : (row - NPROMPT);
#pragma unroll
                    for (int bj = 0; bj < 2; ++bj) {
                        const int pc = bj ? (pos & 63) : (pos >> 6);
                        const float* tc = tab + pc * 16 + fo;
#pragma unroll
                        for (int n = 0; n < 2; ++n) {
                            const f32x4 cs = *(const f32x4*)(tc + 4 * n), sn = *(const f32x4*)(tc + 4096 + 4 * n);
                            f32x4 o;
#pragma unroll
                            for (int r = 0; r < 4; ++r) { const float xn = x[bj][n][r] * rh * gg[bj][n][r]; const float pr = __shfl_xor(xn, 32); o[r] = (xn * cs[r] + sgn * pr * sn[r]) * osc; }
                            x[bj][n] = o;
                        }
                    }
                }
#pragma unroll
                for (int bj = 0; bj < 2; ++bj) {
                    v4u w; w.x = pk2(x[bj][0][0], x[bj][0][1]); w.y = pk2(x[bj][0][2], x[bj][0][3]); w.z = pk2(x[bj][1][0], x[bj][1][1]); w.w = pk2(x[bj][1][2], x[bj][1][3]);
                    *(v4u*)(O + (size_t)row * NQKV + pn * 256 + 64 * wc + 32 * bj + 8 * fq) = w;
                }
            }
    }
};

__device__ __forceinline__ void transpose_item(const float* W, int K, int N, bf16* WT, LAS float* scr, int item, int lane, const float* gk, const bool permq) {
    const int nblk = (N + 31) / 32, kb = item / nblk, nb = item % nblk, k0 = 64 * kb, n0 = 32 * nb;
    const int nn = n0 + (lane & 31);
#pragma unroll 8
    for (int i = 0; i < 32; ++i) { const int kk = 2 * i + (lane >> 5); scr[kk * 33 + (lane & 31)] = (nn < N) ? W[(size_t)(k0 + kk) * N + nn] * (gk ? gk[k0 + kk] : 1.f) : 0.f; }
    LDS_WAIT(); asm volatile("" ::: "memory");
    const int c = lane & 7;
#pragma unroll
    for (int j = 0; j < 4; ++j) { const int n = (lane >> 3) + 8 * j; const LAS float* s = scr + (8 * c) * 33 + n;
        v4u o; o.x = pk2(s[0 * 33], s[1 * 33]); o.y = pk2(s[2 * 33], s[3 * 33]); o.z = pk2(s[4 * 33], s[5 * 33]); o.w = pk2(s[6 * 33], s[7 * 33]);
        const int cq = n0 + n, rowo = permq ? ((cq & ~255) + 128 * ((cq >> 5) & 1) + 32 * ((cq >> 6) & 3) + (cq & 31)) : cq;
        *(v4u*)(WT + (size_t)rowo * K + k0 + 8 * c) = o; }
    LDS_WAIT(); asm volatile("" ::: "memory");
}
__device__ __forceinline__ void convert_weights(const float* W, int K, int N, bf16* WT, LAS float* scr, int gw, int NGW, int lane, const float* gk = nullptr, const bool permq = false) {
    const int items = (K / 64) * ((N + 31) / 32);
    for (int it = gw; it < items; it += NGW) transpose_item(W, K, N, WT, scr, it, lane, gk, permq);
}
__device__ __forceinline__ void cvt_row(const float* xrow, bf16* orow, float* ssq, int lane) {
    const f32x4* xr = (const f32x4*)xrow + lane;
    f32x4 v[4]; float s = 0.f;
#pragma unroll
    for (int j = 0; j < 4; ++j) { v[j] = xr[64 * j]; s += (v[j].x * v[j].x + v[j].y * v[j].y) + (v[j].z * v[j].z + v[j].w * v[j].w); }
    s = wave_sum(s);
    unsigned long long* o8 = (unsigned long long*)orow + lane;
#pragma unroll
    for (int j = 0; j < 4; ++j) o8[64 * j] = (unsigned long long)pk2(v[j].x, v[j].y) | ((unsigned long long)pk2(v[j].z, v[j].w) << 32);
    if (lane == 0) *ssq = s;
}

__device__ __forceinline__ s16x4 trrd(LAS unsigned char* p) { return __builtin_bit_cast(s16x4, __builtin_amdgcn_ds_read_tr16_b64_v4i16((LAS s16x4*)p)); }
#define MFMA16(a, b, c) __builtin_amdgcn_mfma_f32_16x16x32_bf16((a), (b), (c), 0, 0, 0)
#define ROWG(c_, j_) (rowbase + (dir ? (L - 1 - ((c_) * 128 + (j_))) : ((c_) * 128 + (j_))))
constexpr int ST_SLOT = 10304;
#define DPPF(old, x, ctrl, rm) __builtin_bit_cast(float, __builtin_amdgcn_update_dpp(__builtin_bit_cast(int, (float)(old)), __builtin_bit_cast(int, (float)(x)), (ctrl), (rm), 0xf, false))
#define MBAR() asm volatile("s_waitcnt lgkmcnt(0)\n\ts_barrier" ::: "memory")
template <int W, bool SO>
__device__ __forceinline__ void mlstm_item(LAS unsigned char* lds, const bf16* __restrict__ proj, bf16* __restrict__ hout, const float* __restrict__ bgate,
                                           const int rowbase, const int L, const int head, const int dir, const int slice,
                                           const int cbeg, const int cend, float* st_save, const float* st_prev, const int nprev) {
    constexpr int ET = W / 16 + 1, PQB = 288, PVB = (W + 16 + 8) * 2, VCH = W / 8, NVR = W / 32;
    constexpr int OFF_Q = 0, OFF_K = 36864, OFF_P = 73728  , OFF_V = 110592, OFF_C = OFF_V + 22528, OFF_G = OFF_C + 23040;
    static_assert(OFF_G + 2304 <= LDS_BYTES - 64, "mlstm LDS map");
    static_assert(ET * 4 * 512 + 2 <= ST_SLOT, "state slot");
    const int tid = threadIdx.x, lane = tid & 63, w = __builtin_amdgcn_readfirstlane(tid >> 6), l15 = lane & 15, q = lane >> 4;
    const float qscale = 0.08838834764831845f;
    const float bg_i = bgate[dir * 8 + head], bg_f = bgate[dir * 8 + 4 + head];
    for (int i = tid; i < 128 * 16; i += 512) { const int r = i >> 4, cc = i & 15; *(LAS bf16*)(lds + OFF_V + r * PVB + (W + cc) * 2) = (cc == 0) ? (bf16)0x3F80 : (bf16)0; }
    f32x4 Cacc[ET];
#pragma unroll
    for (int e = 0; e < ET; ++e) Cacc[e] = (f32x4){0.f, 0.f, 0.f, 0.f};
    float m_old = -1e30f, bsum = 0.f;
    if constexpr (!SO) {
        for (int sg = 0; sg < nprev; ++sg) {
            const float* p = st_prev + (size_t)sg * 4 * ST_SLOT;
            const float ms = p[10240], Bs = p[10241];
            const float mn = fmaxf(Bs + m_old, ms), f1 = fexp(Bs + m_old - mn), f2 = fexp(ms - mn);
#pragma unroll
            for (int e = 0; e < ET; ++e)
#pragma unroll
                for (int r = 0; r < 4; ++r) Cacc[e][r] = f1 * Cacc[e][r] + f2 * p[(e * 4 + r) * 512 + tid];
            m_old = mn;
        }
#pragma unroll
        for (int et = 0; et < ET; ++et) { v2u o; o.x = pk2(Cacc[et][0], Cacc[et][1]); o.y = pk2(Cacc[et][2], Cacc[et][3]);
            *(LAS v2u*)(lds + OFF_C + (16 * et + l15) * PQB + (16 * w + 4 * q) * 2) = o; }
    }
    v4u rq[4], rk[4], rv[NVR]; unsigned short gl[2], gf[2];
#define MLOAD(c_) do { \
    _Pragma("unroll") for (int i_ = 0; i_ < 4; ++i_) { const int id_ = tid + 512 * i_, r_ = id_ >> 4, ch_ = id_ & 15; \
        const bf16* src_ = proj + (size_t)ROWG(c_, r_) * N_IN_PAD + head * 128 + ch_ * 8; if constexpr (!SO) rq[i_] = *(const v4u*)src_; rk[i_] = *(const v4u*)(src_ + 512); } \
    _Pragma("unroll") for (int i_ = 0; i_ < NVR; ++i_) { const int id_ = tid + 512 * i_, r_ = id_ / VCH, ch_ = id_ % VCH; \
        rv[i_] = *(const v4u*)(proj + (size_t)ROWG(c_, r_) * N_IN_PAD + 1024 + head * 256 + slice * W + ch_ * 8); } \
  } while (0)
#define GLOAD(c_) do { _Pragma("unroll") for (int e_ = 0; e_ < 2; ++e_) { const bf16* g_ = proj + (size_t)ROWG(c_, 2 * lane + e_) * N_IN_PAD + 3072 + dir * 8 + head; gl[e_] = g_[0]; gf[e_] = g_[4]; } } while (0)
#define SCAN(par_) do { LAS float* sa_ = (LAS float*)(lds + OFF_P + (par_) * 2304); LAS float* sM_ = sa_ + 128; LAS float* smr_ = sa_ + 256; LAS float* swk_ = sa_ + 384; LAS float* sc_ = sa_ + 512; \
            const float li0 = bf1(gl[0]) + bg_i, li1 = bf1(gl[1]) + bg_i, f0 = bf1(gf[0]) + bg_f, f1 = bf1(gf[1]) + bg_f; \
            const float lf0 = fminf(f0, 0.f) - flog(1.f + fexp(-fabsf(f0))), lf1 = fminf(f1, 0.f) - flog(1.f + fexp(-fabsf(f1))); \
            const float p = lf0 + lf1; float incl = p; \
            incl += DPPF(0.f, incl, 0x111, 0xf); incl += DPPF(0.f, incl, 0x112, 0xf); incl += DPPF(0.f, incl, 0x114, 0xf); incl += DPPF(0.f, incl, 0x118, 0xf); \
            incl += DPPF(0.f, incl, 0x142, 0xa); incl += DPPF(0.f, incl, 0x143, 0xc); \
            const float b0 = (incl - p) + lf0, b1 = incl; \
            const float a0 = li0 - b0, a1 = li1 - b1; \
            float im = fmaxf(a0, a1); \
            im = fmaxf(im, DPPF(-3e38f, im, 0x111, 0xf)); im = fmaxf(im, DPPF(-3e38f, im, 0x112, 0xf)); im = fmaxf(im, DPPF(-3e38f, im, 0x114, 0xf)); im = fmaxf(im, DPPF(-3e38f, im, 0x118, 0xf)); \
            im = fmaxf(im, DPPF(-3e38f, im, 0x142, 0xa)); im = fmaxf(im, DPPF(-3e38f, im, 0x143, 0xc)); \
            float ex = __shfl_up(im, 1); ex = (lane == 0) ? m_old : fmaxf(ex, m_old); \
            const float M0 = fmaxf(ex, a0), M1 = fmaxf(M0, a1); \
            const float M_last = __builtin_bit_cast(float, __builtin_amdgcn_readlane(__builtin_bit_cast(int, M1), 63)), b_last = __builtin_bit_cast(float, __builtin_amdgcn_readlane(__builtin_bit_cast(int, b1), 63)); \
            sa_[2 * lane] = a0; sa_[2 * lane + 1] = a1; sM_[2 * lane] = M0; sM_[2 * lane + 1] = M1; \
            smr_[2 * lane] = b0 + M0; smr_[2 * lane + 1] = b1 + M1; \
            swk_[2 * lane] = fexp(a0 - M_last); swk_[2 * lane + 1] = fexp(a1 - M_last); \
            if (lane == 0) { sc_[0] = M_last; sc_[1] = m_old; } \
            m_old = b_last + M_last; bsum += b_last; \
  } while (0)
    MLOAD(cbeg);
    if (w == 0) { GLOAD(cbeg); SCAN(0); if (cbeg + 1 < cend) GLOAD(cbeg + 1); }
    for (int c = cbeg; c < cend; ++c) {
#pragma unroll
        for (int i = 0; i < 4; ++i) { const int id = tid + 512 * i, r = id >> 4, ch = id & 15;
            if constexpr (!SO) *(LAS v4u*)(lds + OFF_Q + r * PQB + ch * 16) = rq[i];
            *(LAS v4u*)(lds + OFF_K + r * PQB + ch * 16) = rk[i]; }
#pragma unroll
        for (int i = 0; i < NVR; ++i) { const int id = tid + 512 * i, r = id / VCH, ch = id % VCH; *(LAS v4u*)(lds + OFF_V + r * PVB + ch * 16) = rv[i]; }
        MBAR();
        if (c + 1 < cend) MLOAD(c + 1);
        if (w == 0 && c + 1 < cend) { SCAN((c + 1 - cbeg) & 1); if (c + 2 < cend) GLOAD(c + 2); }
        LAS float* sa = (LAS float*)(lds + OFF_P + ((c - cbeg) & 1) * 2304); LAS float* sM = sa + 128; LAS float* smr = sa + 256; LAS float* swk = sa + 384; LAS float* sc = sa + 512;
        (void)sM; (void)smr;
        const float M_last = sc[0], m_prev = sc[1];
        if constexpr (!SO) {
        const int wq = (w < 4) ? w : 11 - w;
        const int j = 16 * wq + l15;
        const float Mj = sM[j], mrow = smr[j];
        const float winter = fexp(m_prev - Mj) * qscale;
        bf16x8 qf[4];
#pragma unroll
        for (int kk = 0; kk < 4; ++kk) qf[kk] = *(LAS bf16x8*)(lds + OFF_Q + j * PQB + (32 * kk + 8 * q) * 2);
        bf16x8 pf[4];
#pragma unroll
        for (int g4 = 0; g4 < 2; ++g4) {
            f32x4 acc[4];
#pragma unroll
            for (int t = 0; t < 4; ++t) acc[t] = (f32x4){0.f, 0.f, 0.f, 0.f};
            if (4 * g4 <= wq) {
                bf16x8 kf[4][4]; f32x4 a4[4];
#pragma unroll
                for (int t = 0; t < 4; ++t) {
#pragma unroll
                    for (int kk = 0; kk < 4; ++kk) kf[t][kk] = *(LAS bf16x8*)(lds + OFF_K + (16 * (4 * g4 + t) + l15) * PQB + (32 * kk + 8 * q) * 2);
                    a4[t] = *(LAS f32x4*)(sa + 16 * (4 * g4 + t) + 4 * q);
                }
#pragma unroll
                for (int kk = 0; kk < 4; ++kk)
#pragma unroll
                    for (int t = 0; t < 4; ++t) acc[t] = MFMA16(kf[t][kk], qf[kk], acc[t]);
#pragma unroll
                for (int t = 0; t < 4; ++t)
#pragma unroll
                    for (int r = 0; r < 4; ++r) { const int s_idx = 16 * (4 * g4 + t) + 4 * q + r; acc[t][r] = (s_idx <= j) ? fexp(fminf(a4[t][r] - Mj, 0.f)) * acc[t][r] * qscale : 0.f; }
            }
#pragma unroll
            for (int h = 0; h < 2; ++h) { v4u pw; pw.x = pk2(acc[2 * h][0], acc[2 * h][1]); pw.y = pk2(acc[2 * h][2], acc[2 * h][3]); pw.z = pk2(acc[2 * h + 1][0], acc[2 * h + 1][1]); pw.w = pk2(acc[2 * h + 1][2], acc[2 * h + 1][3]);
                pf[2 * g4 + h] = __builtin_bit_cast(bf16x8, pw); }
        }
        f32x4 nv[ET];
#pragma unroll
        for (int et = 0; et < ET; ++et) {
            f32x4 intra = (f32x4){0.f, 0.f, 0.f, 0.f}, inter = (f32x4){0.f, 0.f, 0.f, 0.f};
            s16x4 t0[4], t1[4]; bf16x8 cf[4];
#pragma unroll
            for (int kk = 0; kk < 4; ++kk) {
                LAS unsigned char* vp = lds + OFF_V + (32 * kk + 4 * q + (l15 >> 2)) * PVB + (16 * et + 4 * (lane & 3)) * 2;
                t0[kk] = trrd(vp); t1[kk] = trrd(vp + 16 * PVB);
                cf[kk] = *(LAS bf16x8*)(lds + OFF_C + (16 * et + l15) * PQB + (32 * kk + 8 * q) * 2);
            }
#pragma unroll
            for (int kk = 0; kk < 4; ++kk) {
                const bf16x8 vf = (bf16x8){t0[kk][0], t0[kk][1], t0[kk][2], t0[kk][3], t1[kk][0], t1[kk][1], t1[kk][2], t1[kk][3]};
                intra = MFMA16(vf, pf[kk], intra);
                inter = MFMA16(cf[kk], qf[kk], inter);
            }
            nv[et] = intra + inter * winter;
        }
        {
            const float den = __shfl(nv[ET - 1][0], l15);
            const float inv = 1.0f / fmaxf(fabsf(den), fexp(-mrow));
            bf16* op = hout + (size_t)ROWG(c, j) * DMOD + head * 256 + slice * W + 4 * q;
#pragma unroll
            for (int et = 0; et < ET - 1; ++et) { v2u o; o.x = pk2(nv[et][0] * inv, nv[et][1] * inv); o.y = pk2(nv[et][2] * inv, nv[et][3] * inv); *(v2u*)(op + 16 * et) = o; }
        }
        }
        {
            const float decay = fexp(m_prev - M_last);
#pragma unroll
            for (int et = 0; et < ET; ++et) Cacc[et] = Cacc[et] * decay;
#pragma unroll
            for (int kk = 0; kk < 4; ++kk) {
                LAS unsigned char* kp = lds + OFF_K + (32 * kk + 8 * q + (l15 >> 2)) * PQB + (16 * w + 4 * (lane & 3)) * 2;
                const s16x4 k0 = trrd(kp), k1 = trrd(kp + 4 * PQB);
                const f32x4 w0 = *(LAS f32x4*)(swk + 32 * kk + 8 * q), w1 = *(LAS f32x4*)(swk + 32 * kk + 8 * q + 4);
                v4u kw;
                kw.x = pk2(bf1((unsigned short)k0[0]) * w0[0], bf1((unsigned short)k0[1]) * w0[1]); kw.y = pk2(bf1((unsigned short)k0[2]) * w0[2], bf1((unsigned short)k0[3]) * w0[3]);
                kw.z = pk2(bf1((unsigned short)k1[0]) * w1[0], bf1((unsigned short)k1[1]) * w1[1]); kw.w = pk2(bf1((unsigned short)k1[2]) * w1[2], bf1((unsigned short)k1[3]) * w1[3]);
                const bf16x8 kt = __builtin_bit_cast(bf16x8, kw);
                s16x4 u0[ET], u1[ET];
#pragma unroll
                for (int et = 0; et < ET; ++et) {
                    LAS unsigned char* vp = lds + OFF_V + (32 * kk + 8 * q + (l15 >> 2)) * PVB + (16 * et + 4 * (lane & 3)) * 2;
                    u0[et] = trrd(vp); u1[et] = trrd(vp + 4 * PVB);
                }
#pragma unroll
                for (int et = 0; et < ET; ++et) {
                    const bf16x8 vf = (bf16x8){u0[et][0], u0[et][1], u0[et][2], u0[et][3], u1[et][0], u1[et][1], u1[et][2], u1[et][3]};
                    Cacc[et] = MFMA16(kt, vf, Cacc[et]);
                }
            }
        }
        MBAR();
        if constexpr (!SO) {
#pragma unroll
        for (int et = 0; et < ET; ++et) { v2u o; o.x = pk2(Cacc[et][0], Cacc[et][1]); o.y = pk2(Cacc[et][2], Cacc[et][3]);
            *(LAS v2u*)(lds + OFF_C + (16 * et + l15) * PQB + (16 * w + 4 * q) * 2) = o; }
        }
    }
    if constexpr (SO) {
#pragma unroll
        for (int e = 0; e < ET; ++e)
#pragma unroll
            for (int r = 0; r < 4; ++r) st_save[(e * 4 + r) * 512 + tid] = Cacc[e][r];
        if (tid == 0) { st_save[10240] = m_old; st_save[10241] = bsum; }
    }
    __syncthreads();
#undef MLOAD
#undef GLOAD
#undef SCAN
}

#define XB_TMO      128
#define XB_XCNT(j)  (256  + 64 * (j))
#define XB_XSUB(j)  (1280 + 64 * (j))
#define XB_XGEN(j)  (2304 + 64 * (j))
#define XB_TOP      3328
#define XB_TOPGEN   3392
#define XCD_BAR_WORDS 3456
#define XB_SPIN_CAP (1u << 18)

__device__ __forceinline__ unsigned xb_ld(unsigned* p)              { return __hip_atomic_load(p, __ATOMIC_RELAXED, __HIP_MEMORY_SCOPE_AGENT); }
__device__ __forceinline__ unsigned xb_add(unsigned* p, unsigned v) { return __hip_atomic_fetch_add(p, v, __ATOMIC_RELAXED, __HIP_MEMORY_SCOPE_AGENT); }
__device__ __forceinline__ unsigned xb_xcc_id() { return (unsigned)__builtin_amdgcn_s_getreg((3 << 11) | 20) & 0xFu; }
#define XB_SPIN(cond, bar) do { unsigned _sp = 0; while (cond) { __builtin_amdgcn_s_sleep(1); \
    if ((++_sp & 255u) == 0u) { if (xb_ld(&(bar)[XB_TMO])) break; if (_sp > XB_SPIN_CAP) { atomicAdd(&(bar)[XB_TMO], 1u); break; } } } } while (0)

struct XcdBarrier {
    unsigned* bar; unsigned x;
    volatile LAS unsigned* st;
};

__device__ __forceinline__ XcdBarrier xcd_barrier_post(unsigned* bar, volatile LAS unsigned* st) {
    XcdBarrier b; b.bar = bar; b.x = xb_xcc_id(); b.st = st;
    if (threadIdx.x == 0) (void)xb_add(&bar[XB_XCNT(b.x)], 1u);
    return b;
}
__device__ __forceinline__ void xcd_barrier_complete(unsigned* bar, unsigned x, unsigned& nloc, unsigned& nx) {
    const unsigned G = gridDim.x * gridDim.y * gridDim.z;
    unsigned sum, cnt, mine, sp = 0u;
    for (;;) {
        sum = 0u; cnt = 0u; mine = 0u;
#pragma unroll
        for (unsigned j = 0; j < 16; ++j) { const unsigned c = xb_ld(&bar[XB_XCNT(j)]); sum += c; cnt += (c > 0u) ? 1u : 0u; mine = (j == x) ? c : mine; }
        if (sum == G) break;
        __builtin_amdgcn_s_sleep(1);
        if ((++sp & 255u) == 0u) { if (xb_ld(&bar[XB_TMO])) break; if (sp > XB_SPIN_CAP) { atomicAdd(&bar[XB_TMO], 1u); break; } }
    }
    nloc = mine > 0u ? mine : 1u; nx = cnt > 0u ? cnt : 1u;
}

__device__ __forceinline__ void xcd_barrier(const XcdBarrier& b) {
    asm volatile("s_waitcnt vmcnt(0)" ::: "memory");
    __syncthreads();
    if (threadIdx.x == 0) {
        unsigned* bar = b.bar;
        __builtin_amdgcn_s_waitcnt(0);
        unsigned nloc = b.st[0], nx = b.st[1];
        if (nloc == 0u) { xcd_barrier_complete(bar, b.x, nloc, nx); b.st[0] = nloc; b.st[1] = nx; }
        const unsigned old = xb_add(&bar[XB_XSUB(b.x)], 1u);
        const unsigned gen = old / nloc;
        if (old + 1u == (gen + 1u) * nloc) {
            __builtin_amdgcn_fence(__ATOMIC_RELEASE, "agent");
            asm volatile("s_waitcnt vmcnt(0)" ::: "memory");
            const unsigned og = xb_add(&bar[XB_TOP], 1u);
            const unsigned tg = og / nx;
            if (og + 1u == (tg + 1u) * nx) xb_add(&bar[XB_TOPGEN], 1u);
            else XB_SPIN(xb_ld(&bar[XB_TOPGEN]) == tg, bar);
            __builtin_amdgcn_fence(__ATOMIC_ACQUIRE, "agent");
            xb_add(&bar[XB_XGEN(b.x)], 1u);
            asm volatile("s_waitcnt vmcnt(0)" ::: "memory");
        } else {
            XB_SPIN(xb_ld(&bar[XB_XGEN(b.x)]) == gen, bar);
            __builtin_amdgcn_fence(__ATOMIC_ACQUIRE, "agent");
            asm volatile("s_waitcnt vmcnt(0)" ::: "memory");
        }
    }
    __syncthreads();
}


template <class T> __device__ __forceinline__ T* opq(T* p) { size_t z = 0; asm volatile("" : "+s"(z)); return (T*)((unsigned char*)p + z); }
#define PTRS unsigned char* ws = opq(args.ws); float* out = opq(args.out); const float* xp = args.in[0]; const float* xs = args.in[1]; \
    bf16* WA = (bf16*)(ws + WS_WA); bf16* WB = (bf16*)(ws + WS_WB); bf16* WU = (bf16*)(ws + WS_WU); bf16* WD = (bf16*)(ws + WS_WD); bf16* XN = (bf16*)(ws + WS_XN); bf16* BIG = (bf16*)(ws + WS_BIG); \
    float* ST = (float*)(ws + WS_ST); bf16* HF = (bf16*)out; bf16* HB = HF + (size_t)T_TOK * DMOD; float* SS1 = (float*)(ws + WS_SS); float* SS2 = SS1 + T_TOK; float* SS3 = SS2 + T_TOK; float* SS0 = SS3 + T_TOK; (void)SS0; \
    bf16* W2A = (bf16*)(ws + WS_W2A); bf16* W2B = (bf16*)(ws + WS_W2B); \
    (void)xp; (void)xs; (void)WA; (void)WB; (void)WU; (void)WD; (void)XN; (void)BIG; (void)ST; (void)HF; (void)HB; (void)SS1; (void)SS2; (void)SS3; (void)W2A; (void)W2B
template <int N, int K, int LDA, class Epi>
__device__ __forceinline__ void run_gemm(LAS unsigned char* lds, const bf16* A, const bf16* Bt, const Epi E, int G, int bx) {
    pg8::Gemm g{A, Bt, T_TOK, N, K, LDA}; pg8::StaticOrder S; S.init(T_TOK, N, G, bx);
    pg8::gemm_phase<Epi, pg8::StaticOrder, PG8_ALIGN, PG8_SP2>(lds, g, S, E);
}
struct Args { const float* in[14]; float* out; unsigned char* ws; int ph_lo, ph_hi; };
__global__ void __launch_bounds__(NWAVES * 64, 2) mk_fwd(Args args) {
    extern __shared__ __attribute__((aligned(16))) unsigned char lds_raw[];
    cg::grid_group grid = cg::this_grid();
    LAS unsigned char* lds = (LAS unsigned char*)lds_raw;
    const int tid = threadIdx.x, lane = tid & 63, wave = __builtin_amdgcn_readfirstlane(tid >> 6);
    const int G = gridDim.x, bx = blockIdx.x, vcu = (G % 8 == 0) ? (bx % 8) * (G / 8) + bx / 8 : bx;
    const int gw = bx * NWAVES + wave, NGW = G * NWAVES;
    LAS float* scr = (LAS float*)(lds + wave * 16384);
    volatile LAS unsigned* bst = (volatile LAS unsigned*)(lds + LDS_BYTES - 64);
    if (tid == 0) { bst[0] = 0u; bst[1] = 0u; }
    __syncthreads();
    (void)xcd_barrier_post((unsigned*)args.ws, bst);

    const int lo = args.ph_lo, hi = args.ph_hi;
#define IN(k) (lo <= (k) && (k) < hi)
#define SEAM(k) do { if (IN(k) && IN((k) + 1)) { if (lo < 0) grid.sync(); else { XcdBarrier xb_; xb_.bar = (unsigned*)opq(args.ws); xb_.x = xb_xcc_id(); xb_.st = bst; xcd_barrier(xb_); } } } while (0)
    if (IN(PH_PRE0)) { PTRS;
        convert_weights(args.in[4], DMOD, N_IN, WA, scr, gw, NGW, lane, args.in[2], true);
        for (int i = gw * 64 + lane; i < 4096; i += NGW * 64) { const float ang = (float)(i >> 4) * powf(10000.f, -(float)(2 * (i & 15)) * (1.f / 32.f)); float* tb = (float*)(ws + WS_TAB); tb[i] = cosf(ang); tb[4096 + i] = sinf(ang); }
        for (int m = gw; m < T_TOK; m += NGW) { const float* xr = (m < NPROMPT) ? xp + (size_t)m * DMOD : xs + (size_t)(m - NPROMPT) * DMOD; cvt_row(xr, XN + (size_t)m * DMOD, SS0 + m, lane); }
    }
    SEAM(PH_PRE0);
    if (IN(PH_INPROJ)) { PTRS; run_gemm<3072, DMOD, DMOD, pg8::EpiBf16<0>>(lds, XN, WA, pg8::EpiBf16<0>{BIG, N_IN_PAD, nullptr, 0, 0, 1.f, SS0}, G, bx);
        {
            const bf16* Wg = WA + (size_t)3072 * DMOD;
            const int l15g = lane & 15, qg = lane >> 4;
            for (int blk = gw; blk < T_TOK / 16; blk += NGW) {
                const int r0 = blk * 16;
                f32x4 ga = (f32x4){0.f, 0.f, 0.f, 0.f};
                const bf16* ap = XN + (size_t)(r0 + l15g) * DMOD + 8 * qg;
                const bf16* bp = Wg + (size_t)l15g * DMOD + 8 * qg;
#pragma unroll 8
                for (int sk = 0; sk < 32; ++sk) { const bf16x8 av = *(const bf16x8*)(ap + 32 * sk); const bf16x8 bv = *(const bf16x8*)(bp + 32 * sk); ga = MFMA16(av, bv, ga); }
#pragma unroll
                for (int r = 0; r < 4; ++r) { const int row = r0 + 4 * qg + r;
                    const float rs = 1.0f / sqrtf(SS0[row] * (1.0f / 1024.0f) + 1e-6f);
                    BIG[(size_t)row * N_IN_PAD + 3072 + l15g] = (bf16)(pk2(ga[r] * rs, 0.f) & 0xffffu); }
            }
        }
    }
    SEAM(PH_INPROJ);
#ifndef SKIP_MLSTM
    if (IN(PH_MA)) { PTRS;
        for (int it = vcu; it < 608; it += G) {
            int ci, seg, slice = it & 3;
            if (it < 384) { ci = it / 12; seg = (it >> 2) % 3; } else { const int i2 = it - 384; ci = 32 + i2 / 28; seg = (i2 >> 2) % 7; }
            const bool smp = ci >= 32; const int cc = smp ? ci - 32 : ci;
            const int head = smp ? (cc >> 1) : ((cc >> 1) & 3), dir = cc & 1, rowbase = smp ? NPROMPT : (cc >> 3) * 8192, L = smp ? 16384 : 8192;
            mlstm_item<64, true>(lds, BIG, nullptr, args.in[5], rowbase, L, head, dir, slice, seg * 16, seg * 16 + 16, ST + (size_t)((ci * 8 + seg) * 4 + slice) * ST_SLOT, nullptr, 0);
        }
            {
            int first = 608 - 2 * G; if (first < 0 || first >= G) first = 0;
            if (vcu >= first) { const int gw2 = (vcu - first) * NWAVES + wave, NGW2 = (G - first) * NWAVES;
                convert_weights(args.in[7], DMOD, DMOD, WB, scr, gw2, NGW2, lane);
                convert_weights(args.in[12], DMOD, FF, WU, scr, gw2, NGW2, lane, args.in[3], true); convert_weights(args.in[13], FF, DMOD, WD, scr, gw2, NGW2, lane);
                convert_weights(args.in[8], DMOD, NQKV, W2A, scr, gw2, NGW2, lane, args.in[2] + DMOD, true); convert_weights(args.in[11], DMOD, DMOD, W2B, scr, gw2, NGW2, lane); }
        }
    }
    SEAM(PH_MA);
    if (IN(PH_MB)) { PTRS;
        for (int it = vcu; it < 768; it += G) {
            int ci, seg, slice = it & 3;
            if (it < 512) { ci = it >> 4; seg = (it >> 2) & 3; } else { const int i2 = it - 512; ci = 32 + (i2 >> 5); seg = (i2 >> 2) & 7; }
            const bool smp = ci >= 32; const int cc = smp ? ci - 32 : ci;
            const int head = smp ? (cc >> 1) : ((cc >> 1) & 3), dir = cc & 1, rowbase = smp ? NPROMPT : (cc >> 3) * 8192, L = smp ? 16384 : 8192;
            mlstm_item<64, false>(lds, BIG, dir ? HB : HF, args.in[5], rowbase, L, head, dir, slice, seg * 16, seg * 16 + 16, nullptr, ST + (size_t)((ci * 8) * 4 + slice) * ST_SLOT, seg);
        }
    }
#endif
    SEAM(PH_MB);
#ifndef SKIP_GATE
    if (IN(PH_GATE)) { PTRS;
            const float* gh = args.in[6];
            for (int m = gw; m < T_TOK; m += NGW) {
                v4u f[2], b_[2], o_[2];
#pragma unroll
                for (int h2 = 0; h2 < 2; ++h2) { const int c0 = 512 * h2 + 8 * lane;
                    f[h2] = *(const v4u*)(HF + (size_t)m * DMOD + c0); b_[h2] = *(const v4u*)(HB + (size_t)m * DMOD + c0); o_[h2] = *(const v4u*)(BIG + (size_t)m * N_IN_PAD + 2048 + c0); }
#pragma unroll
                for (int h2 = 0; h2 < 2; ++h2) { const int c0 = 512 * h2 + 8 * lane;
                    float hs[8], og[8];
#pragma unroll
                    for (int i = 0; i < 4; ++i) { hs[2 * i] = bflo(f[h2][i]) + bflo(b_[h2][i]); hs[2 * i + 1] = bfhi(f[h2][i]) + bfhi(b_[h2][i]); og[2 * i] = bflo(o_[h2][i]); og[2 * i + 1] = bfhi(o_[h2][i]); }
                    float s = 0.f;
#pragma unroll
                    for (int i = 0; i < 8; ++i) s += hs[i] * hs[i];
                    s += __shfl_xor(s, 1); s += __shfl_xor(s, 2); s += __shfl_xor(s, 4); s += __shfl_xor(s, 8); s += __shfl_xor(s, 16);
                    const float r = 1.0f / sqrtf(s * (1.f / 256.f) + EPS);
                    const f32x4 g0 = *(const f32x4*)(gh + c0), g1 = *(const f32x4*)(gh + c0 + 4);
                    float y[8];
#pragma unroll
                    for (int i = 0; i < 4; ++i) { y[i] = hs[i] * r * g0[i] / (1.0f + fexp(-og[i])); y[4 + i] = hs[4 + i] * r * g1[i] / (1.0f + fexp(-og[4 + i])); }
                    v4u yo; yo.x = pk2(y[0], y[1]); yo.y = pk2(y[2], y[3]); yo.z = pk2(y[4], y[5]); yo.w = pk2(y[6], y[7]);
                    *(v4u*)(BIG + (size_t)m * N_IN_PAD + c0) = yo;
                }
            }
    }
#endif
    SEAM(PH_GATE);
    if (IN(PH_OUTPROJ)) { PTRS; run_gemm<DMOD, DMOD, N_IN_PAD, EpiRes<1>>(lds, BIG, WB, EpiRes<1>{nullptr, nullptr, 0, nullptr, DMOD, XN, SS1}, G, bx); }
    SEAM(PH_OUTPROJ);
    if (IN(PH_UP0)) { PTRS; run_gemm<FF, DMOD, DMOD, pg8::EpiBf16<2>>(lds, XN, WU, pg8::EpiBf16<2>{BIG, FF, nullptr, 0, 0, 1.f, nullptr}, G, bx); }
    SEAM(PH_UP0);
    if (IN(PH_DOWN0)) { PTRS; run_gemm<DMOD, FF, FF, EpiRes<1>>(lds, BIG, WD, EpiRes<1>{nullptr, SS1, 0, nullptr, DMOD, XN, SS2}, G, bx); }
    SEAM(PH_DOWN0);
    if (IN(PH_QKV)) { PTRS; run_gemm<NQKV, DMOD, DMOD, EpiQKV>(lds, XN, W2A, EpiQKV{BIG, SS2, args.in[9], args.in[10], (const float*)(ws + WS_TAB)}, G, bx);
        {
            const int nun = (T_TOK / 256) * (NQKV / 256); int first = nun % G; if (first == 0) first = 0;
            const int nconv = G - first;
            if (bx >= first) { const int gw2 = (bx - first) * NWAVES + wave, NGW2 = nconv * NWAVES;
                convert_weights(args.in[12] + (size_t)DMOD * FF, DMOD, FF, WU, scr, gw2, NGW2, lane, args.in[3] + DMOD, true); convert_weights(args.in[13] + (size_t)DMOD * FF, FF, DMOD, WD, scr, gw2, NGW2, lane); }
        }
    }
    SEAM(PH_QKV);
#ifndef SKIP_ATTN
    if (IN(PH_ATTN)) { PTRS;
            const attn_body::bf16* Qp = (const attn_body::bf16*)BIG; const attn_body::bf16* Kp = Qp + 1024; const attn_body::bf16* Vp = Qp + 1280; attn_body::bf16* Op = (attn_body::bf16*)BIG;
            float gqm = fabsf(args.in[9][lane]), gkm = fabsf(args.in[10][lane]);
#pragma unroll
            for (int o = 1; o < 64; o <<= 1) { gqm = fmaxf(gqm, __shfl_xor(gqm, o)); gkm = fmaxf(gkm, __shfl_xor(gkm, o)); }
            const float mref = 8.0f * gqm * gkm * 1.4426950408889634f * 1.03f + 0.25f;
            if (G == 256) {
                if (vcu < 128) {
                    const int seq = vcu >> 5, cl = vcu & 31;
                    for (int i = 0; i < 16; ++i) attn_body::attn_unit<8>(mref, (long)seq * 8192, 8192, 4 * (i >> 2) + (cl & 3), 4 * (cl >> 2) + (i & 3), Qp, Kp, Vp, Op, (char*)lds_raw); }
                else { const int v = vcu - 128, head = v >> 3, qb0 = (v & 7) * 8;
                    for (int i = 0; i < 8; ++i) attn_body::attn_unit<8>(mref, (long)NPROMPT, 16384, head, qb0 + i, Qp, Kp, Vp, Op, (char*)lds_raw); }
            } else {
                for (int u = vcu; u < 3072; u += G) {
                    if (u < 2048) attn_body::attn_unit<8>(mref, (long)(u >> 9) * 8192, 8192, (u >> 5) & 15, u & 31, Qp, Kp, Vp, Op, (char*)lds_raw);
                    else { const int u2 = u - 2048; attn_body::attn_unit<8>(mref, (long)NPROMPT, 16384, u2 >> 6, u2 & 63, Qp, Kp, Vp, Op, (char*)lds_raw); }
                }
            }
    }
#endif
    SEAM(PH_ATTN);
    if (IN(PH_OPROJ)) { PTRS; run_gemm<DMOD, DMOD, NQKV, EpiRes<1>>(lds, BIG, W2B, EpiRes<1>{nullptr, nullptr, 0, nullptr, DMOD, XN, SS3}, G, bx); }
    SEAM(PH_OPROJ);
    if (IN(PH_UP1)) { PTRS; run_gemm<FF, DMOD, DMOD, pg8::EpiBf16<2>>(lds, XN, WU, pg8::EpiBf16<2>{BIG, FF, nullptr, 0, 0, 1.f, nullptr}, G, bx); }
    SEAM(PH_UP1);
    if (IN(PH_DOWN1)) { PTRS; run_gemm<DMOD, FF, FF, EpiRes<2>>(lds, BIG, WD, EpiRes<2>{nullptr, SS3, 0, out, DMOD, XN, nullptr}, G, bx); }
#undef IN
#undef SEAM
}

extern "C" void kernel_launch(void* const* d_in, const int* in_sizes, int n_in, void* d_out, int out_size, void* d_ws, size_t ws_size, hipStream_t stream) {
    static int grid = 0;
    if (grid == 0) {
        if (n_in != 14 || out_size != T_TOK * DMOD || ws_size < WS_END) { fprintf(stderr, "kernel_launch: unexpected shapes: n_in %d out %d ws %zu (need %zu)\n", n_in, out_size, ws_size, (size_t)WS_END); grid = -1; return; }
        int dev = 0, cus = 0, per_cu = 0;
        if (hipGetDevice(&dev) != hipSuccess || hipDeviceGetAttribute(&cus, hipDeviceAttributeMultiprocessorCount, dev) != hipSuccess) { grid = -1; return; }
        if (hipFuncSetAttribute((const void*)mk_fwd, hipFuncAttributeMaxDynamicSharedMemorySize, LDS_BYTES) != hipSuccess) { fprintf(stderr, "kernel_launch: hipFuncSetAttribute failed\n"); grid = -1; return; }
        if (hipOccupancyMaxActiveBlocksPerMultiprocessor(&per_cu, (const void*)mk_fwd, NWAVES * 64, LDS_BYTES) != hipSuccess || per_cu < 1) per_cu = 1;
        (void)hipGetLastError();
        grid = cus * per_cu;
    }
    if (grid < 0) return;
    if (hipMemsetAsync(d_ws, 0, CTL_ZERO_BYTES, stream) != hipSuccess) { fprintf(stderr, "kernel_launch: memset of the barrier words failed\n"); return; }
    Args a{};
    for (int i = 0; i < 14; ++i) a.in[i] = (const float*)d_in[i];
    a.out = (float*)d_out; a.ws = (unsigned char*)d_ws;
#if MK_N_LAUNCHES == 1
    a.ph_lo = 0; a.ph_hi = NPHASE;
    void* kargs[] = {&a};
    hipError_t e = hipLaunchCooperativeKernel((const void*)mk_fwd, dim3(grid), dim3(NWAVES * 64), kargs, LDS_BYTES, stream);
    if (e != hipSuccess) fprintf(stderr, "cooperative launch failed: %s (grid %d)\n", hipGetErrorString(e), grid);
#else
    for (int ph = 0; ph < NPHASE; ++ph) {
        a.ph_lo = ph; a.ph_hi = ph + 1;
        hipLaunchKernelGGL(mk_fwd, dim3(grid), dim3(NWAVES * 64), LDS_BYTES, stream, a);
#ifdef PROBE_MASK
        if ((PROBE_MASK >> ph) & 1) hipLaunchKernelGGL(mk_fwd, dim3(grid), dim3(NWAVES * 64), LDS_BYTES, stream, a);
#endif
    }
#endif
}
```

```cpp
#include <hip/hip_runtime.h>
#include <hip/hip_cooperative_groups.h>
#include <cstdio>
#include <cstdint>
#include <hip/hip_bf16.h>
#include <cmath>
namespace cg = cooperative_groups;
namespace pg8 {
#define PG8_LAS __attribute__((address_space(3)))
typedef unsigned short bf16_t;
typedef short bf16x8 __attribute__((ext_vector_type(8)));
typedef float f32x4 __attribute__((ext_vector_type(4)));
typedef unsigned u32x4 __attribute__((ext_vector_type(4)));
constexpr int BM = 256, BK = 64, HALF = 128, HTB = HALF * BK * 2  , STAGE_BYTES = 8 * HTB, NXCD = 8, WGM = 8;

__host__ __device__ __forceinline__ int lds_byte(int r, int c) { const int st = (r >> 4) * 2 + (c >> 5), rr = r & 15, cc = c & 31, ob = rr * 64 + cc * 2; return st * 1024 + (ob ^ (((ob >> 9) & 1) << 5)); }
__host__ __device__ __forceinline__ void stage_rc(int b, int& R, int& C) { const int st = b / 1024, sb = b % 1024, swz = sb ^ (((sb >> 9) & 1) << 5); R = (st >> 1) * 16 + swz / 64; C = (st & 1) * 32 + (swz % 64) / 2; }
__host__ __device__ __forceinline__ int perm32(int rho) { const int n = rho >> 4, i = rho & 15; return 8 * (i >> 2) + 4 * n + (i & 3); }

struct Unit { int pm, pn; };
struct Gemm { const bf16_t* A; const bf16_t* Bt; int M, N, K, lda; };

struct StaticOrder {
    int nM, nN, nwg, G, c;
    __host__ __device__ void init(int M, int N, int G_, int c_) { nM = M / BM; nN = N / BM; nwg = nM * nN; G = G_; c = c_; }
    __host__ __device__ bool next(int i, Unit& u) const {
        const long L = (long)i * G + c; if (L >= nwg) return false;
        int wgid = (int)L; { const int q = nwg / NXCD, r = nwg % NXCD, xcd = wgid % NXCD, off = wgid / NXCD; wgid = (xcd < r ? xcd * (q + 1) : r * (q + 1) + (xcd - r) * q) + off; }
        const int nig = WGM * nN, gid = wgid / nig, fm = gid * WGM, gsz = (nM - fm) < WGM ? (nM - fm) : WGM;
        u.pm = fm + ((wgid % nig) % gsz); u.pn = (wgid % nig) / gsz; return true;
    }
    __device__ __forceinline__ void a_ready(const Unit&) const {}
    __device__ __forceinline__ void done(const Unit&) const {}
};

__device__ __forceinline__ unsigned cvt_pk_bf16(float lo, float hi) { unsigned r; asm volatile("v_cvt_pk_bf16_f32 %0, %1, %2" : "=v"(r) : "v"(lo), "v"(hi)); return r; }
typedef float f32x2 __attribute__((ext_vector_type(2)));
__device__ __forceinline__ f32x2 gelu_pk(f32x2 v) {
    const f32x2 av = __builtin_elementwise_abs(v), d = av * 0.2316418882f + 1.0f;
    f32x2 t; t.x = __builtin_amdgcn_rcpf(d.x); t.y = __builtin_amdgcn_rcpf(d.y);
    f32x2 q = t * 0.5307027145f + (-0.7265760135f); q = q * t + 0.7107068705f; q = q * t + (-0.142248368f); q = q * t + 0.127414796f; q = q * t;
    const f32x2 s = (v * v) * (-0.72134752044f);
    f32x2 e; e.x = __builtin_amdgcn_exp2f(s.x); e.y = __builtin_amdgcn_exp2f(s.y);
    const f32x2 m = v * (q * e), r = v - m;
    f32x2 o; o.x = v.x < 0.f ? m.x : r.x; o.y = v.y < 0.f ? m.y : r.y; return o;
}

template <int ACT  > struct EpiBf16 {
    static constexpr bool PERM = true, AFTER_DRAIN = false; static_assert(ACT == 0 || ACT == 2, "EpiBf16: ACT is 0 (none) or 2 (squared relu)");
    bf16_t* O; int ldc; const float* bias; int split_cols; size_t split_stride; float scale0; const float* ss;
    __device__ __forceinline__ void operator()(const f32x4 (&acc)[2][2][4][2], const Unit& u, int wr, int wc, int fr, int fq) const {
        const bool lo = fr < 8;
        bf16_t* cbase = O + u.pn * BM + 64 * wc + 8 * fq;
        float rsv[2][4];
#pragma unroll
        for (int ai = 0; ai < 2; ++ai)
#pragma unroll
            for (int m = 0; m < 4; ++m) rsv[ai][m] = ss ? ss[u.pm * BM + wr * 64 + ai * HALF + m * 16 + fr] : 1.0f;
#pragma unroll
        for (int ai = 0; ai < 2; ++ai)
#pragma unroll
            for (int m = 0; m < 4; ++m) rsv[ai][m] = ss ? 1.0f / sqrtf(rsv[ai][m] * (1.0f / 1024.0f) + 1e-6f) : 1.0f;
#pragma unroll
        for (int ai = 0; ai < 2; ++ai)
#pragma unroll
            for (int m = 0; m < 4; ++m) {
                const int rbase = u.pm * BM + wr * 64 + ai * HALF + m * 16;
                const float rs = rsv[ai][m];
                u32x4 w[2];
#pragma unroll
                for (int bj = 0; bj < 2; ++bj) { f32x4 v0 = acc[ai][bj][m][0] * rs, v1 = acc[ai][bj][m][1] * rs;
                    if (ACT == 2) { _Pragma("unroll") for (int q_ = 0; q_ < 4; ++q_) { const float a_ = fmaxf(v0[q_], 0.f), b_ = fmaxf(v1[q_], 0.f); v0[q_] = a_ * a_; v1[q_] = b_ * b_; } }
                    w[bj].x = cvt_pk_bf16(v0[0], v0[1]); w[bj].y = cvt_pk_bf16(v0[2], v0[3]); w[bj].z = cvt_pk_bf16(v1[0], v1[1]); w[bj].w = cvt_pk_bf16(v1[2], v1[3]); }
                u32x4 bx;
#pragma unroll
                for (int k = 0; k < 4; ++k) bx[k] = (unsigned)__builtin_amdgcn_update_dpp(0, (int)w[1][k], 0x128, 0xf, 0xf, false);
                const u32x4 s1 = lo ? w[0] : bx, s2 = lo ? bx : w[0];
                bf16_t* p1 = cbase + (size_t)(rbase + (fr & 7)) * ldc + (lo ? 0 : 32);
                bf16_t* p2 = cbase + (size_t)(rbase + 8 + (fr & 7)) * ldc + (lo ? 32 : 0);
                if (ACT == 2) { __builtin_nontemporal_store(s1, (u32x4*)p1); __builtin_nontemporal_store(s2, (u32x4*)p2); }
                else { *(u32x4*)p1 = s1; *(u32x4*)p2 = s2; }
            }
    }
};

template <class Epi, class Sched, bool ALIGN_EPI = false, bool SP2 = false>
__device__ __forceinline__ void gemm_phase(PG8_LAS unsigned char* lds, const Gemm g, const Sched& S, const Epi& E) {
    const int tid = threadIdx.x, wid = __builtin_amdgcn_readfirstlane(tid >> 6), lane = tid & 63, wr = wid >> 2, wc = wid & 3, fr = lane & 15, fq = lane >> 4;
    const int K = g.K, nt = K / BK;
    unsigned voffA[2], voffB[2];
#pragma unroll
    for (int i = 0; i < 2; ++i) { int R, C; stage_rc(tid * 16 + i * 8192, R, C); const int Rb = Epi::PERM ? ((R & ~31) + perm32(R & 31)) : R;
        voffA[i] = (unsigned)(R * g.lda + C) * 2u; voffB[i] = (unsigned)(Rb * K + C) * 2u; }
    const size_t kstep = (size_t)(BK * 2);
    const size_t hstep = (size_t)HALF * K * 2;
    const size_t tstep = 2 * hstep;
    const size_t hstepA = (size_t)HALF * g.lda * 2, tstepA = 2 * hstepA;
    const unsigned ldsw = (unsigned)wid * 1024u;
    const int aoff = lds_byte(wr * 64 + fr, fq * 8), boff = lds_byte(wc * 32 + fr, fq * 8);
#define PG8_SA(b, h) (((b) * 2 + (h)) * HTB)
#define PG8_SB(b, h) ((4 + (b) * 2 + (h)) * HTB)
#define PG8_STAGE(bufoff, gbase, voff) do { _Pragma("unroll") for (int _i = 0; _i < 2; ++_i) \
        __builtin_amdgcn_global_load_lds((const unsigned*)((const char*)(gbase) + (voff)[_i]), (PG8_LAS unsigned*)(lds + (bufoff) + ldsw + _i * 8192), 16, 0, 0); } while (0)
#define PG8_LDA(dst, b, h) do { _Pragma("unroll") for (int m = 0; m < 4; ++m) _Pragma("unroll") for (int k = 0; k < 2; ++k) dst[m][k] = *(const PG8_LAS bf16x8*)(lds + PG8_SA(b, h) + aoff + m * 2048 + k * 1024); } while (0)
#define PG8_LDB(dst, b, h) do { _Pragma("unroll") for (int n = 0; n < 2; ++n) _Pragma("unroll") for (int k = 0; k < 2; ++k) dst[n][k] = *(const PG8_LAS bf16x8*)(lds + PG8_SB(b, h) + boff + n * 2048 + k * 1024); } while (0)
#define PG8_MMA(ai, bj, At, Bt) do { __builtin_amdgcn_s_setprio(1); _Pragma("unroll") for (int m = 0; m < 4; ++m) _Pragma("unroll") for (int n = 0; n < 2; ++n) _Pragma("unroll") for (int k = 0; k < 2; ++k) \
        acc[ai][bj][m][n] = __builtin_amdgcn_mfma_f32_16x16x32_bf16(Bt[n][k], At[m][k], acc[ai][bj][m][n], 0, 0, 0); __builtin_amdgcn_s_setprio(0); } while (0)
#define PG8_WAIT_V(n) asm volatile("s_waitcnt vmcnt(" #n ")" ::: "memory")
#define PG8_WAIT_L(n) asm volatile("s_waitcnt lgkmcnt(" #n ")" ::: "memory")
#define PG8_BAR __builtin_amdgcn_s_barrier()
#define PG8_SCHED __builtin_amdgcn_sched_barrier(0)
    Unit cur, nxt; int ui = 0;
    if (!S.next(0, cur)) return;
    f32x4 acc[2][2][4][2];
#pragma unroll
    for (int a = 0; a < 2; ++a)
#pragma unroll
        for (int b = 0; b < 2; ++b)
#pragma unroll
            for (int m = 0; m < 4; ++m)
#pragma unroll
                for (int n = 0; n < 2; ++n) acc[a][b][m][n] = (f32x4){0.f, 0.f, 0.f, 0.f};
    bf16x8 At[4][2], B0[2][2], B1[2][2];
    const char* cA = (const char*)g.A + (size_t)cur.pm * tstepA; const char* cB = (const char*)g.Bt + (size_t)cur.pn * tstep;
    S.a_ready(cur);
    if constexpr (SP2) {
        PG8_STAGE(PG8_SB(0, 0), cB, voffB); PG8_STAGE(PG8_SB(0, 1), cB + hstep, voffB); PG8_STAGE(PG8_SA(0, 0), cA, voffA); PG8_STAGE(PG8_SA(0, 1), cA + hstepA, voffA);
        if (wr == 1) PG8_BAR;
        PG8_WAIT_V(2); PG8_BAR;
        PG8_STAGE(PG8_SB(1, 0), cB + kstep, voffB); PG8_STAGE(PG8_SA(1, 0), cA + kstep, voffA); PG8_STAGE(PG8_SB(1, 1), cB + hstep + kstep, voffB);
        PG8_WAIT_V(6); PG8_BAR;
    } else {
        PG8_STAGE(PG8_SB(0, 0), cB, voffB); PG8_STAGE(PG8_SA(0, 0), cA, voffA); PG8_STAGE(PG8_SB(0, 1), cB + hstep, voffB); PG8_STAGE(PG8_SA(0, 1), cA + hstepA, voffA);
        if (wr == 1) PG8_BAR;
        PG8_WAIT_V(4); PG8_BAR;
        PG8_STAGE(PG8_SB(1, 0), cB + kstep, voffB); PG8_STAGE(PG8_SA(1, 0), cA + kstep, voffA); PG8_STAGE(PG8_SB(1, 1), cB + hstep + kstep, voffB);
        PG8_WAIT_V(6); PG8_BAR;
    }
    for (;;) {
        const bool has_next = S.next(ui + 1, nxt);
        const char* nA = has_next ? (const char*)g.A + (size_t)nxt.pm * tstepA : cA; const char* nB = has_next ? (const char*)g.Bt + (size_t)nxt.pn * tstep : cB;
        for (int t = 0; t < nt; t += 2) {
            const bool last = (t == nt - 2);
            const char* a1 = cA + (size_t)(t + 1) * kstep;
            const char* a2 = last ? nA : cA + (size_t)(t + 2) * kstep; const char* b2 = last ? nB : cB + (size_t)(t + 2) * kstep;
            const char* a3 = a2 + kstep; const char* b3 = b2 + kstep;
            if (last && has_next) S.a_ready(nxt);
            if constexpr (SP2) {
            PG8_LDB(B0, 0, 0); PG8_LDB(B1, 0, 1); PG8_SCHED; PG8_LDA(At, 0, 0); PG8_STAGE(PG8_SA(1, 1), a1 + hstepA, voffA);
            PG8_WAIT_V(8); PG8_WAIT_L(0); PG8_BAR; PG8_MMA(0, 0, At, B0); PG8_MMA(0, 1, At, B1); PG8_BAR; PG8_SCHED;
            PG8_LDA(At, 0, 1); PG8_STAGE(PG8_SB(0, 0), b2, voffB); PG8_STAGE(PG8_SB(0, 1), b2 + hstep, voffB); PG8_STAGE(PG8_SA(0, 0), a2, voffA);
            PG8_WAIT_V(8); PG8_WAIT_L(0); PG8_BAR; PG8_MMA(1, 0, At, B0); PG8_MMA(1, 1, At, B1); PG8_BAR; PG8_SCHED;
            PG8_LDB(B0, 1, 0); PG8_LDB(B1, 1, 1); PG8_SCHED; PG8_LDA(At, 1, 0); PG8_STAGE(PG8_SA(0, 1), a2 + hstepA, voffA);
            PG8_WAIT_V(8); PG8_WAIT_L(0); PG8_BAR; PG8_MMA(0, 0, At, B0); PG8_MMA(0, 1, At, B1); PG8_BAR; PG8_SCHED;
            PG8_LDA(At, 1, 1); PG8_STAGE(PG8_SB(1, 0), b3, voffB); PG8_STAGE(PG8_SB(1, 1), b3 + hstep, voffB); PG8_STAGE(PG8_SA(1, 0), a3, voffA);
            PG8_WAIT_V(8); PG8_WAIT_L(0); PG8_BAR; PG8_MMA(1, 0, At, B0); PG8_MMA(1, 1, At, B1); PG8_BAR; PG8_SCHED;
            } else {
            PG8_LDB(B0, 0, 0); PG8_SCHED; PG8_LDA(At, 0, 0); PG8_STAGE(PG8_SA(1, 1), a1 + hstepA, voffA);
            PG8_WAIT_L(8); PG8_BAR; PG8_WAIT_L(0); PG8_MMA(0, 0, At, B0); PG8_BAR; PG8_SCHED;
            PG8_LDB(B1, 0, 1); PG8_STAGE(PG8_SB(0, 0), b2, voffB);
            PG8_BAR; PG8_WAIT_L(0); PG8_MMA(0, 1, At, B1); PG8_BAR;
            PG8_LDA(At, 0, 1); PG8_STAGE(PG8_SA(0, 0), a2, voffA);
            PG8_BAR; PG8_WAIT_L(0); PG8_MMA(1, 0, At, B0); PG8_BAR; PG8_SCHED;
            PG8_STAGE(PG8_SB(0, 1), b2 + hstep, voffB);
            PG8_WAIT_V(6); PG8_BAR; PG8_MMA(1, 1, At, B1); PG8_BAR;
            PG8_LDB(B0, 1, 0); PG8_SCHED; PG8_LDA(At, 1, 0); PG8_STAGE(PG8_SA(0, 1), a2 + hstepA, voffA);
            PG8_WAIT_L(8); PG8_BAR; PG8_WAIT_L(0); PG8_MMA(0, 0, At, B0); PG8_BAR; PG8_SCHED;
            PG8_LDB(B1, 1, 1); PG8_STAGE(PG8_SB(1, 0), b3, voffB);
            PG8_BAR; PG8_WAIT_L(0); PG8_MMA(0, 1, At, B1); PG8_BAR;
            PG8_LDA(At, 1, 1); PG8_STAGE(PG8_SA(1, 0), a3, voffA);
            PG8_BAR; PG8_WAIT_L(0); PG8_MMA(1, 0, At, B0); PG8_BAR; PG8_SCHED;
            PG8_STAGE(PG8_SB(1, 1), b3 + hstep, voffB);
            PG8_WAIT_V(6); PG8_BAR; PG8_MMA(1, 1, At, B1); PG8_BAR;
            }
        }
        if constexpr (ALIGN_EPI) { if (wr == 0) PG8_BAR; }
        if constexpr (!Epi::AFTER_DRAIN) { E(acc, cur, wr, wc, fr, fq); S.done(cur); }
        if (!has_next) break;
#pragma unroll
        for (int a = 0; a < 2; ++a)
#pragma unroll
            for (int b = 0; b < 2; ++b)
#pragma unroll
                for (int m = 0; m < 4; ++m)
#pragma unroll
                    for (int n = 0; n < 2; ++n) acc[a][b][m][n] = (f32x4){0.f, 0.f, 0.f, 0.f};
        cur = nxt; cA = nA; cB = nB; ++ui;
        if constexpr (ALIGN_EPI) { if (wr == 1) PG8_BAR; }
    }
    PG8_WAIT_V(0);
    if constexpr (!ALIGN_EPI) { if (wr == 0) PG8_BAR; }
    PG8_BAR;
    if constexpr (Epi::AFTER_DRAIN) { E.fused(acc, cur, wr, wc, fr, fq, lds, wid, lane); S.done(cur); }
#undef PG8_SA
#undef PG8_SB
#undef PG8_STAGE
#undef PG8_LDA
#undef PG8_LDB
#undef PG8_MMA
#undef PG8_WAIT_V
#undef PG8_WAIT_L
#undef PG8_BAR
#undef PG8_SCHED
}
}

#ifndef PG8_SP2
#define PG8_SP2 true
#endif
#ifndef PG8_ALIGN
#define PG8_ALIGN true
#endif
namespace attn_body {
using bf16=__hip_bfloat16;
using bf16x8=__attribute__((ext_vector_type(8)))short;
using s16x4=__attribute__((ext_vector_type(4)))short;
using f32x16=__attribute__((ext_vector_type(16)))float;
using u32x4=__attribute__((ext_vector_type(4)))unsigned;
constexpr int NHEAD=16,D=64,DM=1536,OPITCH=1536,GQ=4;
constexpr int NW=8,QBLK=32,QB=QBLK*NW,KVBLK=64;
constexpr int ATTN_PITCH=DM, ATTN_UNIT_ROWS=QB;
__device__ __forceinline__ int crow(int r,int hi){return (r&3)+8*(r>>2)+4*hi;}
#define SBAR() __builtin_amdgcn_sched_barrier(0)
__device__ __forceinline__ void cmask(f32x16&p0,f32x16&p1,int jb,int qrel,int hi){
  const float NEG=-INFINITY; int kb=64*jb+4*hi;
  #pragma unroll
  for(int r=0;r<16;++r){int kv=kb+(r&3)+8*(r>>2); if(kv>qrel)p0[r]=NEG; if(kv+32>qrel)p1[r]=NEG;}
}

constexpr int NSLOT=3, SLOTB=8192;
constexpr int LDS_K=0, LDS_V=NSLOT*SLOTB, LDS_WS=2*NSLOT*SLOTB, LDS_OST=LDS_WS+NW*64*4, LDS_BYTES=LDS_OST+NW*4096;
constexpr float C2=0.125f*1.4426950408889634f;
__device__ __forceinline__ void glds16(const void*gsrc,unsigned lds_dst){unsigned keep;
  asm volatile("s_mov_b32 %0, m0\n\ts_mov_b32 m0, %2\n\ts_nop 0\n\tglobal_load_lds_dwordx4 %1, off\n\ts_mov_b32 m0, %0":"=&s"(keep):"v"(gsrc),"s"(lds_dst):"memory");}
__device__ __forceinline__ float max3f(float a,float b,float c){float r;asm("v_max3_f32 %0, %1, %2, %3":"=v"(r):"v"(a),"v"(b),"v"(c));return r;}
__device__ __forceinline__ float max2f(float a,float b){float r;asm("v_max_f32_e32 %0, %1, %2":"=v"(r):"v"(a),"v"(b));return r;}
__device__ __forceinline__ float fadd_s(float a,float b){float r;asm("v_add_f32_e32 %0, %1, %2":"=v"(r):"v"(a),"v"(b));return r;}
__device__ __forceinline__ float fsub_s(float a,float b){float r;asm("v_sub_f32_e32 %0, %1, %2":"=v"(r):"v"(a),"v"(b));return r;}
typedef float f32x2_t __attribute__((ext_vector_type(2))); typedef __bf16 bf16x2_t __attribute__((ext_vector_type(2)));
__device__ __forceinline__ unsigned cvtpk_s(float lo,float hi){f32x2_t v={lo,hi};bf16x2_t b=__builtin_convertvector(v,bf16x2_t);return __builtin_bit_cast(unsigned,b);}
#define WAIT_BAR(N) asm volatile("s_waitcnt vmcnt(" #N ") lgkmcnt(0)\n\ts_barrier":::"memory")

__device__ __forceinline__ void qkt(f32x16&p0,f32x16&p1,const char*Kslot,const bf16x8*qr,const f32x16&negm,int r32,int hi){
  const char*kb=Kslot+hi*1024+r32*16;
  #pragma unroll
  for(int d0=0;d0<4;++d0){
    const bf16x8 b0=*reinterpret_cast<const bf16x8*>(kb+d0*2048);
    const bf16x8 b1=*reinterpret_cast<const bf16x8*>(kb+d0*2048+512);
    if(d0==0){p0=__builtin_amdgcn_mfma_f32_32x32x16_bf16(b0,qr[0],negm,0,0,0);p1=__builtin_amdgcn_mfma_f32_32x32x16_bf16(b1,qr[0],negm,0,0,0);}
    else{p0=__builtin_amdgcn_mfma_f32_32x32x16_bf16(b0,qr[d0],p0,0,0,0);p1=__builtin_amdgcn_mfma_f32_32x32x16_bf16(b1,qr[d0],p1,0,0,0);}}
}
typedef __attribute__((address_space(3))) const char* lds_cptr;
typedef short v4i16_t __attribute__((ext_vector_type(4)));
__device__ __forceinline__ void kload8(bf16x8*kf,lds_cptr kp){
  kf[0]=*(const __attribute__((address_space(3))) bf16x8*)(kp);      kf[1]=*(const __attribute__((address_space(3))) bf16x8*)(kp+512);
  kf[2]=*(const __attribute__((address_space(3))) bf16x8*)(kp+2048); kf[3]=*(const __attribute__((address_space(3))) bf16x8*)(kp+2560);
  kf[4]=*(const __attribute__((address_space(3))) bf16x8*)(kp+4096); kf[5]=*(const __attribute__((address_space(3))) bf16x8*)(kp+4608);
  kf[6]=*(const __attribute__((address_space(3))) bf16x8*)(kp+6144); kf[7]=*(const __attribute__((address_space(3))) bf16x8*)(kp+6656);
}
__device__ __forceinline__ void kload2(bf16x8*kf,lds_cptr kp,int j){ kf[2*j]=*(const __attribute__((address_space(3))) bf16x8*)(kp+j*2048); kf[2*j+1]=*(const __attribute__((address_space(3))) bf16x8*)(kp+j*2048+512); }
__device__ __forceinline__ s16x4 vtr(lds_cptr p){ return __builtin_bit_cast(s16x4,__builtin_amdgcn_ds_read_tr16_b64_v4i16((__attribute__((address_space(3))) v4i16_t*)p)); }
__device__ __forceinline__ float rowmax(const f32x16&p0,const f32x16&p1){
  float a=max3f(p0[0],p0[1],p1[0]),b=max3f(p0[2],p0[3],p1[1]);a=max3f(a,p1[2],p1[3]);
  #pragma unroll
  for(int r=4;r<16;r+=4){a=max3f(a,p0[r],p0[r+1]);b=max3f(b,p0[r+2],p0[r+3]);a=max3f(a,p1[r],p1[r+1]);b=max3f(b,p1[r+2],p1[r+3]);}
  const float m=max2f(a,b);
  auto rr=__builtin_amdgcn_permlane32_swap(__float_as_uint(m),__float_as_uint(m),false,false);
  return max2f(__uint_as_float(rr[0]),__uint_as_float(rr[1]));
}
__device__ __forceinline__ void pv(f32x16*o,int vb,bf16x8 pa0,bf16x8 pa1,bf16x8 pa2,bf16x8 pa3){
  #pragma unroll
  for(int d0=0;d0<2;++d0){s16x4 lo[4],hi[4];
    #pragma unroll
    for(int ks=0;ks<4;++ks){
      asm volatile("ds_read_b64_tr_b16 %0,%1 offset:%c2":"=&v"(lo[ks]):"v"(vb),"i"(d0*4096+ks*1024):"memory");
      asm volatile("ds_read_b64_tr_b16 %0,%1 offset:%c2":"=&v"(hi[ks]):"v"(vb),"i"(d0*4096+ks*1024+512):"memory");}
    asm volatile("s_waitcnt lgkmcnt(0)":::"memory");SBAR();
    #define PK(k) (bf16x8){lo[k][0],lo[k][1],lo[k][2],lo[k][3],hi[k][0],hi[k][1],hi[k][2],hi[k][3]}
    o[d0]=__builtin_amdgcn_mfma_f32_32x32x16_bf16(pa0,PK(0),o[d0],0,0,0);
    o[d0]=__builtin_amdgcn_mfma_f32_32x32x16_bf16(pa1,PK(1),o[d0],0,0,0);
    o[d0]=__builtin_amdgcn_mfma_f32_32x32x16_bf16(pa2,PK(2),o[d0],0,0,0);
    o[d0]=__builtin_amdgcn_mfma_f32_32x32x16_bf16(pa3,PK(3),o[d0],0,0,0);
    #undef PK
  }
}

#ifndef ATTN_STORE16
#define ATTN_STORE16(p,v) (*(u32x4*)(p)=(v))
#endif
template<int THRL> __device__ __forceinline__ void attn_unit(const float mref,long rowbase,int SEQ,int h,int qb,const bf16*Q,const bf16*__restrict__ K,const bf16*__restrict__ V,bf16*O,char*shm){
  const int tid=threadIdx.x,lane=tid&63,r32=lane&31,hi=lane>>5; const int wid=__builtin_amdgcn_readfirstlane(tid>>6);
  const int q0=qb*QB;
  const bf16*Qw=Q+(rowbase+q0+wid*QBLK)*DM+h*D;
  const bf16*Kh=K+rowbase*DM+(h/GQ)*D,*Vh=V+rowbase*DM+(h/GQ)*D;
  const unsigned lds0=(unsigned)(uintptr_t)shm;
  float*wsf=(float*)(shm+LDS_WS)+wid*64;
  const bf16*ksrc=Kh+(long)lane*DM+wid*8;
  const bf16*vsrc=Vh+(long)(16*(wid&3)+(lane>>2))*DM+(wid>>2)*32+(lane&3)*8;
  const unsigned kdst=lds0+LDS_K+wid*1024, vdst=lds0+LDS_V+wid*1024;
  #define DMA_K(t,slot) glds16(ksrc+(long)(t)*KVBLK*DM,(unsigned)__builtin_amdgcn_readfirstlane(kdst+(slot)))
  #define DMA_V(t,slot) glds16(vsrc+(long)(t)*KVBLK*DM,(unsigned)__builtin_amdgcn_readfirstlane(vdst+(slot)))
  const int vb0=(int)(lds0+LDS_V)+((lane>>4)&1)*32+(lane&3)*8+(4*hi+((lane&15)>>2))*64;
  const char*Kbase=shm+LDS_K; bf16x8 kf[8];
  const lds_cptr shm3=(lds_cptr)shm; const lds_cptr kp0=shm3+LDS_K+hi*1024+r32*16; const lds_cptr vp0=shm3+LDS_V+((lane>>4)&1)*32+(lane&3)*8+(4*hi+((lane&15)>>2))*64;
  if(wid>=4)__builtin_amdgcn_s_setprio(1);
  const int NT=SEQ/KVBLK;
  DMA_K(0,0);DMA_V(0,0);DMA_K(1,SLOTB);
  bf16x8 qr[4];
  #pragma unroll
  for(int d0=0;d0<4;++d0)qr[d0]=*reinterpret_cast<const bf16x8*>(&Qw[(long)r32*DM+d0*16+hi*8]);
  float mhat=0.f,l_reg=0.f;f32x16 o[2];o[0]=f32x16{};o[1]=f32x16{};f32x16 negm=f32x16{};asm volatile("":"+v"(negm));

  #define CMASK(P0,P1,t) do{}while(0)
  bool resc=false;
  #define START(P0,P1) do{ const float rm=mref; resc=false; \
    { const float dl=rm; mhat=fadd_s(mhat,dl); \
      _Pragma("unroll") for(int r=0;r<16;++r){P0[r]=fsub_s(P0[r],dl);P1[r]=fsub_s(P1[r],dl);} \
      _Pragma("unroll") for(int r=0;r<16;++r)negm[r]=-mhat; asm volatile("":"+v"(negm)); } \
    _Pragma("unroll") for(int r=0;r<16;++r)P0[r]=__builtin_amdgcn_exp2f(P0[r]); }while(0)
  #define RESC() do{ if(resc){ asm volatile("s_waitcnt lgkmcnt(0)":::"memory"); \
      _Pragma("unroll") for(int d_=0;d_<2;++d_) _Pragma("unroll") for(int r=0;r<16;++r)o[d_][r]*=wsf[crow(r,hi)]; } }while(0)
  f32x16 pA0,pA1,pB0,pB1;
  int sl_prev=0,sl_cur=0,sl_next=SLOTB;
  #define ROT() do{sl_prev=sl_cur;sl_cur=sl_next;sl_next=(sl_next==(NSLOT-1)*SLOTB)?0:sl_next+SLOTB;}while(0)
  DMA_K(2,2*SLOTB);
  WAIT_BAR(3);
  qkt(pA0,pA1,Kbase,qr,negm,r32,hi);asm volatile("s_nop 15\n\ts_nop 7":"+v"(pA0),"+v"(pA1));CMASK(pA0,pA1,0);
  START(pA0,pA1);
  _Pragma("unroll") for(int r=0;r<16;++r)pA1[r]=__builtin_amdgcn_exp2f(pA1[r]);
  WAIT_BAR(0);
  DMA_K(3,0);DMA_V(1,SLOTB);
  ROT();
  kload8(kf,kp0+sl_cur);
  WAIT_BAR(2);
  s16x4 vlo[8],vhi[8]; u32x4 pw0,pw1,pw2,pw3;
  #define PKW(P,B) cvtpk_s(P[B],P[B+1])
  #define PAF(k) __builtin_bit_cast(bf16x8,pw##k)
  #define VFR(i) (bf16x8){vlo[i][0],vlo[i][1],vlo[i][2],vlo[i][3],vhi[i][0],vhi[i][1],vhi[i][2],vhi[i][3]}
  #define PIN(x) asm volatile("":"+v"(x))
  #define MX3(a,b,c) __builtin_fmaxf(__builtin_fmaxf((a),(b)),(c))
  #define GAPA(MF,A0,A1,A2,A3,W0,W1,PW) do{ MF; sacc+=A0; sacc+=A1; sacc+=A2; sacc+=A3; PIN(sacc); W0; W1; PIN(PW); SBAR(); }while(0)
  #define EX(v) __builtin_amdgcn_exp2f(v)
  #define GAPB(MF,X,B) do{ MF; X[B]=EX(X[B]); X[B+1]=EX(X[B+1]); X[B+2]=EX(X[B+2]); X[B+3]=EX(X[B+3]); PIN(X); SBAR(); }while(0)
  #define VRD(i) do{ vlo[i]=vtr(vp_+(((i)>>2)*4096+((i)&3)*1024)); vhi[i]=vtr(vp_+(((i)>>2)*4096+((i)&3)*1024+512)); }while(0)
  #define KRD(G,j) do{ if(G){ kload2(kf,kp0+sl_next,j); SBAR(); } }while(0)
  #define STEP(C0,C1,P0,P1,t,GK,GV,GL) do{ SBAR(); \
    const lds_cptr vp_=vp0+sl_prev; \
    VRD(0); SBAR(); float sacc=(P0[0]+P0[1]); \
    GAPA(C0=__builtin_amdgcn_mfma_f32_32x32x16_bf16(kf[0],qr[0],negm,0,0,0), P0[2],P0[3],P0[4],P0[5],     pw0[0]=PKW(P0,0), pw0[1]=PKW(P0,2), pw0); \
    VRD(4); SBAR(); GAPA(C1=__builtin_amdgcn_mfma_f32_32x32x16_bf16(kf[1],qr[0],negm,0,0,0), P0[6],P0[7],P0[8],P0[9],     pw0[2]=PKW(P0,4), pw0[3]=PKW(P0,6), pw0); \
    VRD(1); SBAR(); GAPA(C0=__builtin_amdgcn_mfma_f32_32x32x16_bf16(kf[2],qr[1],C0,0,0,0),   P0[10],P0[11],P0[12],P0[13], pw1[0]=PKW(P0,8), pw1[1]=PKW(P0,10), pw1); \
    VRD(5); SBAR(); GAPA(C1=__builtin_amdgcn_mfma_f32_32x32x16_bf16(kf[3],qr[1],C1,0,0,0),   P0[14],P0[15],P1[0],P1[1],   pw1[2]=PKW(P0,12),pw1[3]=PKW(P0,14), pw1); \
    VRD(2); SBAR(); GAPA(C0=__builtin_amdgcn_mfma_f32_32x32x16_bf16(kf[4],qr[2],C0,0,0,0),   P1[2],P1[3],P1[4],P1[5],     pw2[0]=PKW(P1,0), pw2[1]=PKW(P1,2), pw2); \
    VRD(6); SBAR(); GAPA(C1=__builtin_amdgcn_mfma_f32_32x32x16_bf16(kf[5],qr[2],C1,0,0,0),   P1[6],P1[7],P1[8],P1[9],     pw2[2]=PKW(P1,4), pw2[3]=PKW(P1,6), pw2); \
    VRD(3); SBAR(); GAPA(C0=__builtin_amdgcn_mfma_f32_32x32x16_bf16(kf[6],qr[3],C0,0,0,0),   P1[10],P1[11],P1[12],P1[13], pw3[0]=PKW(P1,8), pw3[1]=PKW(P1,10), pw3); \
    VRD(7); SBAR(); GAPA(C1=__builtin_amdgcn_mfma_f32_32x32x16_bf16(kf[7],qr[3],C1,0,0,0),   P1[14],P1[15],0.f,0.f,       pw3[2]=PKW(P1,12),pw3[3]=PKW(P1,14), pw3); \
    l_reg+=sacc; \
    if(GK){DMA_K((t)+3,sl_cur);} if(GV){DMA_V((t)+1,sl_next);} \
    CMASK(C0,C1,t); \
    resc=false;   \
    SBAR(); \
    GAPB(o[0]=__builtin_amdgcn_mfma_f32_32x32x16_bf16(PAF(0),VFR(0),o[0],0,0,0), C0,0); \
    GAPB(o[1]=__builtin_amdgcn_mfma_f32_32x32x16_bf16(PAF(0),VFR(4),o[1],0,0,0), C0,4); \
    KRD(GL,0); GAPB(o[0]=__builtin_amdgcn_mfma_f32_32x32x16_bf16(PAF(1),VFR(1),o[0],0,0,0), C0,8); \
    KRD(GL,1); GAPB(o[1]=__builtin_amdgcn_mfma_f32_32x32x16_bf16(PAF(1),VFR(5),o[1],0,0,0), C0,12); \
    KRD(GL,2); GAPB(o[0]=__builtin_amdgcn_mfma_f32_32x32x16_bf16(PAF(2),VFR(2),o[0],0,0,0), C1,0); \
    KRD(GL,3); GAPB(o[1]=__builtin_amdgcn_mfma_f32_32x32x16_bf16(PAF(2),VFR(6),o[1],0,0,0), C1,4); \
    GAPB(o[0]=__builtin_amdgcn_mfma_f32_32x32x16_bf16(PAF(3),VFR(3),o[0],0,0,0), C1,8); \
    GAPB(o[1]=__builtin_amdgcn_mfma_f32_32x32x16_bf16(PAF(3),VFR(7),o[1],0,0,0), C1,12); \
    }while(0)
  int t=1;
  #undef CMASK
  #define CMASK(P0,P1,t) do{}while(0)
  for(;t+5<NT;t+=2){
    STEP(pB0,pB1,pA0,pA1,t,true,true,true);     WAIT_BAR(2); RESC(); ROT();
    STEP(pA0,pA1,pB0,pB1,t+1,true,true,true);   WAIT_BAR(2); RESC(); ROT();
  }
  #undef CMASK
  #define CMASK(P0,P1,t) do{}while(0)
  #define ENDW(tt) do{ if((tt)+3<NT){WAIT_BAR(2);} else if((tt)+2<NT){WAIT_BAR(1);} else {WAIT_BAR(0);} }while(0)
  for(;t+1<NT;t+=2){
    STEP(pB0,pB1,pA0,pA1,t,(t+3<NT),(t+1<NT),(t+1<NT));       ENDW(t);   RESC(); ROT();
    STEP(pA0,pA1,pB0,pB1,t+1,(t+4<NT),(t+2<NT),(t+2<NT));     ENDW(t+1); RESC(); ROT();
  }
  STEP(pB0,pB1,pA0,pA1,NT-1,false,false,false); RESC();
  { float sacc=pB0[0]+pB0[1]; _Pragma("unroll") for(int r=2;r<16;++r)sacc+=pB0[r]; _Pragma("unroll") for(int r=0;r<16;++r)sacc+=pB1[r]; l_reg+=sacc;
    pw0=(u32x4){PKW(pB0,0),PKW(pB0,2),PKW(pB0,4),PKW(pB0,6)};pw1=(u32x4){PKW(pB0,8),PKW(pB0,10),PKW(pB0,12),PKW(pB0,14)};pw2=(u32x4){PKW(pB1,0),PKW(pB1,2),PKW(pB1,4),PKW(pB1,6)};pw3=(u32x4){PKW(pB1,8),PKW(pB1,10),PKW(pB1,12),PKW(pB1,14)};
    SBAR(); pv(o,vb0+sl_cur,PAF(0),PAF(1),PAF(2),PAF(3)); }
  #undef PKW
  #undef PAF
  #undef VFR
  #undef PIN
  #undef MX3
  #undef GAPA
  #undef GAPB
  #undef EX
  #undef VRD
  #undef KRD
  #undef STEP
  #undef ENDW
  {auto rr=__builtin_amdgcn_permlane32_swap(__float_as_uint(l_reg),__float_as_uint(l_reg),false,false);l_reg=__uint_as_float(rr[0])+__uint_as_float(rr[1]);}
  if(hi==0)wsf[32+r32]=l_reg;asm volatile("s_waitcnt lgkmcnt(0)":::"memory");
  float rli[16];
  #pragma unroll
  for(int r=0;r<16;++r)rli[r]=__builtin_amdgcn_rcpf(wsf[32+crow(r,hi)]);
  bf16*Ow=O+(rowbase+q0+wid*QBLK)*OPITCH+h*D;
  { bf16*stg=(bf16*)(shm+LDS_OST)+wid*2048;
    #pragma unroll
    for(int r=0;r<16;++r){const int orow=crow(r,hi);
      #pragma unroll
      for(int d0=0;d0<2;++d0)stg[orow*64+d0*32+r32]=__float2bfloat16(o[d0][r]*rli[r]);}
    asm volatile("s_waitcnt lgkmcnt(0)":::"memory");
    #pragma unroll
    for(int i=0;i<4;++i){const int row=i*8+(lane>>3),ch=lane&7; const u32x4 v=*(const u32x4*)(stg+row*64+ch*8); ATTN_STORE16(Ow+(long)row*OPITCH+ch*8,v);} }
  __builtin_amdgcn_s_setprio(0);
  asm volatile("s_waitcnt lgkmcnt(0)\n\ts_barrier":::"memory");
  #undef DMA_K
  #undef DMA_V
  #undef CMASK
  #undef START
  #undef RESC
  #undef ROT
}
constexpr int ATTN_LDS_BYTES=LDS_BYTES;
#undef SBAR
#undef WAIT_BAR
}
#define GAS __attribute__((address_space(1)))
#define LAS __attribute__((address_space(3)))
typedef unsigned short bf16;
typedef unsigned v4u __attribute__((ext_vector_type(4)));
typedef unsigned v2u __attribute__((ext_vector_type(2)));
typedef float f32x4 __attribute__((ext_vector_type(4)));
typedef short bf16x8 __attribute__((ext_vector_type(8)));
typedef short s16x4 __attribute__((ext_vector_type(4)));

#ifndef MK_N_LAUNCHES
#define MK_N_LAUNCHES 1
#endif
constexpr int NWAVES = 8;
enum Phase { PH_PRE0 = 0, PH_INPROJ, PH_MA, PH_MB, PH_GATE, PH_OUTPROJ, PH_UP0, PH_DOWN0, PH_QKV, PH_ATTN, PH_OPROJ, PH_UP1, PH_DOWN1, NPHASE };
constexpr int T_TOK = 49152, NPROMPT = 32768, DMOD = 1024, FF = 4096;
constexpr int N_IN = 3088, N_IN_PAD = 3328, NQKV = 1536;
constexpr float EPS = 1e-6f;
constexpr size_t MiB = 1u << 20;
constexpr size_t WS_WA = 1 * MiB, WS_WB = 8 * MiB, WS_WU = 10 * MiB, WS_WD = 18 * MiB, WS_XN = 26 * MiB, WS_BIG = 122 * MiB, WS_ST = 440 * MiB, WS_W2A = 506 * MiB, WS_W2B = 509 * MiB, WS_END = 511 * MiB;
constexpr size_t WS_SS = 65536, WS_TAB = 868352  , CTL_ZERO_BYTES = 1 * MiB;
constexpr int LDS_BYTES = 159744;

__device__ __forceinline__ unsigned f2bf(float f) { unsigned u = __builtin_bit_cast(unsigned, f); return (u + 0x7fffu + ((u >> 16) & 1u)) >> 16; }
typedef float f32x2v_t __attribute__((ext_vector_type(2))); typedef __bf16 bf16x2v_t __attribute__((ext_vector_type(2)));
__device__ __forceinline__ unsigned pk2(float lo, float hi) { f32x2v_t v = {lo, hi}; bf16x2v_t b = __builtin_convertvector(v, bf16x2v_t); return __builtin_bit_cast(unsigned, b); }
__device__ __forceinline__ float bflo(unsigned u) { return __uint_as_float(u << 16); }
__device__ __forceinline__ float bfhi(unsigned u) { return __uint_as_float(u & 0xffff0000u); }
__device__ __forceinline__ float bf1(unsigned short u) { return __uint_as_float(((unsigned)u) << 16); }
__device__ __forceinline__ float wave_sum(float v) {
#pragma unroll
    for (int o = 1; o < 64; o <<= 1) v += __shfl_xor(v, o);
    return v;
}
__device__ __forceinline__ float fexp(float x) { return __builtin_amdgcn_exp2f(x * 1.4426950408889634f); }
__device__ __forceinline__ float flog(float x) { return __builtin_amdgcn_logf(x) * 0.6931471805599453f; }
#define LDS_WAIT() asm volatile("s_waitcnt lgkmcnt(0)" ::: "memory")

template <int MODE> struct EpiRes {
    static constexpr bool PERM = true, AFTER_DRAIN = false;
    const float* base0; const float* base1; int split_row; float* out; int ldc; bf16* xb; float* ss;
    __device__ __forceinline__ void operator()(const pg8::f32x4 (&acc)[2][2][4][2], const pg8::Unit& u, int wr, int wc, int fr, int fq) const {
#pragma unroll
        for (int ai = 0; ai < 2; ++ai) {
            v4u bw[4][2]; f32x4 bf0[4][2], bf1[4][2]; float r2v[4];
#pragma unroll
            for (int m = 0; m < 4; ++m) {
                const int row = u.pm * 256 + ai * 128 + wr * 64 + m * 16 + fr;
                r2v[m] = ((MODE == 1 || MODE == 2) && base1) ? base1[row] : 1.0f;
#pragma unroll
                for (int bj = 0; bj < 2; ++bj) { const int col = u.pn * 256 + bj * 128 + wc * 32 + 8 * fq;
                    if (MODE == 0) { const float* b = (row < split_row) ? base0 + (size_t)row * ldc : base1 + (size_t)(row - split_row) * ldc; bf0[m][bj] = *(const f32x4*)(b + col); bf1[m][bj] = *(const f32x4*)(b + col + 4); }
                    else bw[m][bj] = *(const v4u*)(xb + (size_t)row * ldc + col); }
            }
#pragma unroll
            for (int m = 0; m < 4; ++m) {
                const int row = u.pm * 256 + ai * 128 + wr * 64 + m * 16 + fr;
                float sq = 0.f;
                const float r2 = ((MODE == 1 || MODE == 2) && base1) ? 1.0f / (r2v[m] * (1.0f / 1024.0f) + 1e-6f) : 1.0f;
#pragma unroll
                for (int bj = 0; bj < 2; ++bj) {
                    const int col = u.pn * 256 + bj * 128 + wc * 32 + 8 * fq;
                    f32x4 v0, v1;
                    if (MODE == 0) { v0 = bf0[m][bj]; v1 = bf1[m][bj]; }
                    else { const v4u w_ = bw[m][bj]; v0 = (f32x4){bflo(w_.x), bfhi(w_.x), bflo(w_.y), bfhi(w_.y)}; v1 = (f32x4){bflo(w_.z), bfhi(w_.z), bflo(w_.w), bfhi(w_.w)}; }
                    v0 = v0 + acc[ai][bj][m][0] * r2; v1 = v1 + acc[ai][bj][m][1] * r2;
                    if (MODE == 2) { float* o = out + (size_t)row * ldc + col; __builtin_nontemporal_store(v0, (f32x4*)o); __builtin_nontemporal_store(v1, (f32x4*)(o + 4)); }
                    else {
                        v4u w; w.x = pk2(v0[0], v0[1]); w.y = pk2(v0[2], v0[3]); w.z = pk2(v1[0], v1[1]); w.w = pk2(v1[2], v1[3]);
                        *(v4u*)(xb + (size_t)row * ldc + col) = w;
                        sq += (v0[0] * v0[0] + v0[1] * v0[1]) + (v0[2] * v0[2] + v0[3] * v0[3]) + (v1[0] * v1[0] + v1[1] * v1[1]) + (v1[2] * v1[2] + v1[3] * v1[3]);
                    }
                }
                if (MODE != 2) { sq += __shfl_xor(sq, 16); sq += __shfl_xor(sq, 32); if (fq == 0) atomicAdd(ss + row, sq); }
            }
        }
    }
};

struct EpiQKV {
    static constexpr bool PERM = true, AFTER_DRAIN = false;
    bf16* O; const float* ss; const float* gq; const float* gk; const float* tab;
    __device__ __forceinline__ void operator()(const pg8::f32x4 (&acc)[2][2][4][2], const pg8::Unit& u, int wr, int wc, int fr, int fq) const {
        const int pn = u.pn; const bool rot = pn < 5;
        const float* g = (pn < 4) ? gq : gk;
        f32x4 gg[2][2];
#pragma unroll
        for (int bj = 0; bj < 2; ++bj)
#pragma unroll
            for (int n = 0; n < 2; ++n) gg[bj][n] = *(const f32x4*)(g + 32 * bj + 8 * fq + 4 * n);
        const float osc = (pn < 4) ? attn_body::C2 : 1.f, sgn = (fq & 2) ? 1.f : -1.f;
        const int fo = 8 * (fq & 1);
        float rsv[2][4];
#pragma unroll
        for (int ai = 0; ai < 2; ++ai)
#pragma unroll
            for (int m = 0; m < 4; ++m) rsv[ai][m] = ss[u.pm * 256 + ai * 128 + wr * 64 + m * 16 + fr];
#pragma unroll
        for (int ai = 0; ai < 2; ++ai)
#pragma unroll
            for (int m = 0; m < 4; ++m) {
                const int row = u.pm * 256 + ai * 128 + wr * 64 + m * 16 + fr;
                const float rs = 1.0f / sqrtf(rsv[ai][m] * (1.0f / 1024.0f) + 1e-6f);
                f32x4 x[2][2];
#pragma unroll
                for (int bj = 0; bj < 2; ++bj)
#pragma unroll
                    for (int n = 0; n < 2; ++n) x[bj][n] = acc[ai][bj][m][n] * rs;
                if (rot) {
                    float s = 0.f;
#pragma unroll
                    for (int bj = 0; bj < 2; ++bj)
#pragma unroll
                        for (int n = 0; n < 2; ++n) s += (x[bj][n][0] * x[bj][n][0] + x[bj][n][1] * x[bj][n][1]) + (x[bj][n][2] * x[bj][n][2] + x[bj][n][3] * x[bj][n][3]);
                    s += __shfl_xor(s, 16); s += __shfl_xor(s, 32);
                    const float rh = 1.0f / sqrtf(s * (1.0f / 64.0f) + 1e-6f);
                    const int pos = (row < NPROMPT) ? (row & 8191) : (row - NPROMPT);
#pragma unroll
                    for (int bj = 0; bj < 2; ++bj) {
                        const int pc = bj ? (pos & 63) : (pos >> 6);
                        const float* tc = tab + pc * 16 + fo;
#pragma unroll
                        for (int n = 0; n < 2; ++n) {
                            const f32x4 cs = *(const f32x4*)(tc + 4 * n), sn = *(const f32x4*)(tc + 4096 + 4 * n);
                            f32x4 o;
#pragma unroll
                            for (int r = 0; r < 4; ++r) { const float xn = x[bj][n][r] * rh * gg[bj][n][r]; const float pr = __shfl_xor(xn, 32); o[r] = (xn * cs[r] + sgn * pr * sn[r]) * osc; }
                            x[bj][n] = o;
                        }
                    }
                }
#pragma unroll
                for (int bj = 0; bj < 2; ++bj) {
                    v4u w; w.x = pk2(x[bj][0][0], x[bj][0][1]); w.y = pk2(x[bj][0][2], x[bj][0][3]); w.z = pk2(x[bj][1][0], x[bj][1][1]); w.w = pk2(x[bj][1][2], x[bj][1][3]);
                    *(v4u*)(O + (size_t)row * NQKV + pn * 256 + 64 * wc + 32 * bj + 8 * fq) = w;
                }
            }
    }
};

__device__ __forceinline__ void transpose_item(const float* W, int K, int N, bf16* WT, LAS float* scr, int item, int lane, const float* gk, const bool permq) {
    const int nblk = (N + 31) / 32, kb = item / nblk, nb = item % nblk, k0 = 64 * kb, n0 = 32 * nb;
    const int nn = n0 + (lane & 31);
#pragma unroll 8
    for (int i = 0; i < 32; ++i) { const int kk = 2 * i + (lane >> 5); scr[kk * 33 + (lane & 31)] = (nn < N) ? W[(size_t)(k0 + kk) * N + nn] * (gk ? gk[k0 + kk] : 1.f) : 0.f; }
    LDS_WAIT(); asm volatile("" ::: "memory");
    const int c = lane & 7;
#pragma unroll
    for (int j = 0; j < 4; ++j) { const int n = (lane >> 3) + 8 * j; const LAS float* s = scr + (8 * c) * 33 + n;
        v4u o; o.x = pk2(s[0 * 33], s[1 * 33]); o.y = pk2(s[2 * 33], s[3 * 33]); o.z = pk2(s[4 * 33], s[5 * 33]); o.w = pk2(s[6 * 33], s[7 * 33]);
        const int cq = n0 + n, rowo = permq ? ((cq & ~255) + 128 * ((cq >> 5) & 1) + 32 * ((cq >> 6) & 3) + (cq & 31)) : cq;
        *(v4u*)(WT + (size_t)rowo * K + k0 + 8 * c) = o; }
    LDS_WAIT(); asm volatile("" ::: "memory");
}
__device__ __forceinline__ void convert_weights(const float* W, int K, int N, bf16* WT, LAS float* scr, int gw, int NGW, int lane, const float* gk = nullptr, const bool permq = false) {
    const int items = (K / 64) * ((N + 31) / 32);
    for (int it = gw; it < items; it += NGW) transpose_item(W, K, N, WT, scr, it, lane, gk, permq);
}
__device__ __forceinline__ void cvt_row(const float* xrow, bf16* orow, float* ssq, int lane) {
    const f32x4* xr = (const f32x4*)xrow + lane;
    f32x4 v[4]; float s = 0.f;
#pragma unroll
    for (int j = 0; j < 4; ++j) { v[j] = xr[64 * j]; s += (v[j].x * v[j].x + v[j].y * v[j].y) + (v[j].z * v[j].z + v[j].w * v[j].w); }
    s = wave_sum(s);
    unsigned long long* o8 = (unsigned long long*)orow + lane;
#pragma unroll
    for (int j = 0; j < 4; ++j) o8[64 * j] = (unsigned long long)pk2(v[j].x, v[j].y) | ((unsigned long long)pk2(v[j].z, v[j].w) << 32);
    if (lane == 0) *ssq = s;
}

__device__ __forceinline__ s16x4 trrd(LAS unsigned char* p) { return __builtin_bit_cast(s16x4, __builtin_amdgcn_ds_read_tr16_b64_v4i16((LAS s16x4*)p)); }
#define MFMA16(a, b, c) __builtin_amdgcn_mfma_f32_16x16x32_bf16((a), (b), (c), 0, 0, 0)
#define ROWG(c_, j_) (rowbase + (dir ? (L - 1 - ((c_) * 128 + (j_))) : ((c_) * 128 + (j_))))
constexpr int ST_SLOT = 10304;
#define DPPF(old, x, ctrl, rm) __builtin_bit_cast(float, __builtin_amdgcn_update_dpp(__builtin_bit_cast(int, (float)(old)), __builtin_bit_cast(int, (float)(x)), (ctrl), (rm), 0xf, false))
#define MBAR() asm volatile("s_waitcnt lgkmcnt(0)\n\ts_barrier" ::: "memory")
template <int W, bool SO>
__device__ __forceinline__ void mlstm_item(LAS unsigned char* lds, const bf16* __restrict__ proj, bf16* __restrict__ hout, const float* __restrict__ bgate,
                                           const int rowbase, const int L, const int head, const int dir, const int slice,
                                           const int cbeg, const int cend, float* st_save, const float* st_prev, const int nprev) {
    constexpr int ET = W / 16 + 1, PQB = 288, PVB = (W + 16 + 8) * 2, VCH = W / 8, NVR = W / 32;
    constexpr int OFF_Q = 0, OFF_K = 36864, OFF_P = 73728  , OFF_V = 110592, OFF_C = OFF_V + 22528, OFF_G = OFF_C + 23040;
    static_assert(OFF_G + 2304 <= LDS_BYTES - 64, "mlstm LDS map");
    static_assert(ET * 4 * 512 + 2 <= ST_SLOT, "state slot");
    const int tid = threadIdx.x, lane = tid & 63, w = __builtin_amdgcn_readfirstlane(tid >> 6), l15 = lane & 15, q = lane >> 4;
    const float qscale = 0.08838834764831845f;
    const float bg_i = bgate[dir * 8 + head], bg_f = bgate[dir * 8 + 4 + head];
    for (int i = tid; i < 128 * 16; i += 512) { const int r = i >> 4, cc = i & 15; *(LAS bf16*)(lds + OFF_V + r * PVB + (W + cc) * 2) = (cc == 0) ? (bf16)0x3F80 : (bf16)0; }
    f32x4 Cacc[ET];
#pragma unroll
    for (int e = 0; e < ET; ++e) Cacc[e] = (f32x4){0.f, 0.f, 0.f, 0.f};
    float m_old = -1e30f, bsum = 0.f;
    if constexpr (!SO) {
        for (int sg = 0; sg < nprev; ++sg) {
            const float* p = st_prev + (size_t)sg * 4 * ST_SLOT;
            const float ms = p[10240], Bs = p[10241];
            const float mn = fmaxf(Bs + m_old, ms), f1 = fexp(Bs + m_old - mn), f2 = fexp(ms - mn);
#pragma unroll
            for (int e = 0; e < ET; ++e)
#pragma unroll
                for (int r = 0; r < 4; ++r) Cacc[e][r] = f1 * Cacc[e][r] + f2 * p[(e * 4 + r) * 512 + tid];
            m_old = mn;
        }
#pragma unroll
        for (int et = 0; et < ET; ++et) { v2u o; o.x = pk2(Cacc[et][0], Cacc[et][1]); o.y = pk2(Cacc[et][2], Cacc[et][3]);
            *(LAS v2u*)(lds + OFF_C + (16 * et + l15) * PQB + (16 * w + 4 * q) * 2) = o; }
    }
    v4u rq[4], rk[4], rv[NVR]; unsigned short gl[2], gf[2];
#define MLOAD(c_) do { \
    _Pragma("unroll") for (int i_ = 0; i_ < 4; ++i_) { const int id_ = tid + 512 * i_, r_ = id_ >> 4, ch_ = id_ & 15; \
        const bf16* src_ = proj + (size_t)ROWG(c_, r_) * N_IN_PAD + head * 128 + ch_ * 8; if constexpr (!SO) rq[i_] = *(const v4u*)src_; rk[i_] = *(const v4u*)(src_ + 512); } \
    _Pragma("unroll") for (int i_ = 0; i_ < NVR; ++i_) { const int id_ = tid + 512 * i_, r_ = id_ / VCH, ch_ = id_ % VCH; \
        rv[i_] = *(const v4u*)(proj + (size_t)ROWG(c_, r_) * N_IN_PAD + 1024 + head * 256 + slice * W + ch_ * 8); } \
  } while (0)
#define GLOAD(c_) do { _Pragma("unroll") for (int e_ = 0; e_ < 2; ++e_) { const bf16* g_ = proj + (size_t)ROWG(c_, 2 * lane + e_) * N_IN_PAD + 3072 + dir * 8 + head; gl[e_] = g_[0]; gf[e_] = g_[4]; } } while (0)
#define SCAN(par_) do { LAS float* sa_ = (LAS float*)(lds + OFF_P + (par_) * 2304); LAS float* sM_ = sa_ + 128; LAS float* smr_ = sa_ + 256; LAS float* swk_ = sa_ + 384; LAS float* sc_ = sa_ + 512; \
            const float li0 = bf1(gl[0]) + bg_i, li1 = bf1(gl[1]) + bg_i, f0 = bf1(gf[0]) + bg_f, f1 = bf1(gf[1]) + bg_f; \
            const float lf0 = fminf(f0, 0.f) - flog(1.f + fexp(-fabsf(f0))), lf1 = fminf(f1, 0.f) - flog(1.f + fexp(-fabsf(f1))); \
            const float p = lf0 + lf1; float incl = p; \
            incl += DPPF(0.f, incl, 0x111, 0xf); incl += DPPF(0.f, incl, 0x112, 0xf); incl += DPPF(0.f, incl, 0x114, 0xf); incl += DPPF(0.f, incl, 0x118, 0xf); \
            incl += DPPF(0.f, incl, 0x142, 0xa); incl += DPPF(0.f, incl, 0x143, 0xc); \
            const float b0 = (incl - p) + lf0, b1 = incl; \
            const float a0 = li0 - b0, a1 = li1 - b1; \
            float im = fmaxf(a0, a1); \
            im = fmaxf(im, DPPF(-3e38f, im, 0x111, 0xf)); im = fmaxf(im, DPPF(-3e38f, im, 0x112, 0xf)); im = fmaxf(im, DPPF(-3e38f, im, 0x114, 0xf)); im = fmaxf(im, DPPF(-3e38f, im, 0x118, 0xf)); \
            im = fmaxf(im, DPPF(-3e38f, im, 0x142, 0xa)); im = fmaxf(im, DPPF(-3e38f, im, 0x143, 0xc)); \
            float ex = __shfl_up(im, 1); ex = (lane == 0) ? m_old : fmaxf(ex, m_old); \
            const float M0 = fmaxf(ex, a0), M1 = fmaxf(M0, a1); \
            const float M_last = __builtin_bit_cast(float, __builtin_amdgcn_readlane(__builtin_bit_cast(int, M1), 63)), b_last = __builtin_bit_cast(float, __builtin_amdgcn_readlane(__builtin_bit_cast(int, b1), 63)); \
            sa_[2 * lane] = a0; sa_[2 * lane + 1] = a1; sM_[2 * lane] = M0; sM_[2 * lane + 1] = M1; \
            smr_[2 * lane] = b0 + M0; smr_[2 * lane + 1] = b1 + M1; \
            swk_[2 * lane] = fexp(a0 - M_last); swk_[2 * lane + 1] = fexp(a1 - M_last); \
            if (lane == 0) { sc_[0] = M_last; sc_[1] = m_old; } \
            m_old = b_last + M_last; bsum += b_last; \
  } while (0)
    MLOAD(cbeg);
    if (w == 0) { GLOAD(cbeg); SCAN(0); if (cbeg + 1 < cend) GLOAD(cbeg + 1); }
    for (int c = cbeg; c < cend; ++c) {
#pragma unroll
        for (int i = 0; i < 4; ++i) { const int id = tid + 512 * i, r = id >> 4, ch = id & 15;
            if constexpr (!SO) *(LAS v4u*)(lds + OFF_Q + r * PQB + ch * 16) = rq[i];
            *(LAS v4u*)(lds + OFF_K + r * PQB + ch * 16) = rk[i]; }
#pragma unroll
        for (int i = 0; i < NVR; ++i) { const int id = tid + 512 * i, r = id / VCH, ch = id % VCH; *(LAS v4u*)(lds + OFF_V + r * PVB + ch * 16) = rv[i]; }
        MBAR();
        if (c + 1 < cend) MLOAD(c + 1);
        if (w == 0 && c + 1 < cend) { SCAN((c + 1 - cbeg) & 1); if (c + 2 < cend) GLOAD(c + 2); }
        LAS float* sa = (LAS float*)(lds + OFF_P + ((c - cbeg) & 1) * 2304); LAS float* sM = sa + 128; LAS float* smr = sa + 256; LAS float* swk = sa + 384; LAS float* sc = sa + 512;
        (void)sM; (void)smr;
        const float M_last = sc[0], m_prev = sc[1];
        if constexpr (!SO) {
        const int wq = (w < 4) ? w : 11 - w;
        const int j = 16 * wq + l15;
        const float Mj = sM[j], mrow = smr[j];
        const float winter = fexp(m_prev - Mj) * qscale;
        bf16x8 qf[4];
#pragma unroll
        for (int kk = 0; kk < 4; ++kk) qf[kk] = *(LAS bf16x8*)(lds + OFF_Q + j * PQB + (32 * kk + 8 * q) * 2);
        bf16x8 pf[4];
#pragma unroll
        for (int g4 = 0; g4 < 2; ++g4) {
            f32x4 acc[4];
#pragma unroll
            for (int t = 0; t < 4; ++t) acc[t] = (f32x4){0.f, 0.f, 0.f, 0.f};
            if (4 * g4 <= wq) {
                bf16x8 kf[4][4]; f32x4 a4[4];
#pragma unroll
                for (int t = 0; t < 4; ++t) {
#pragma unroll
                    for (int kk = 0; kk < 4; ++kk) kf[t][kk] = *(LAS bf16x8*)(lds + OFF_K + (16 * (4 * g4 + t) + l15) * PQB + (32 * kk + 8 * q) * 2);
                    a4[t] = *(LAS f32x4*)(sa + 16 * (4 * g4 + t) + 4 * q);
                }
#pragma unroll
                for (int kk = 0; kk < 4; ++kk)
#pragma unroll
                    for (int t = 0; t < 4; ++t) acc[t] = MFMA16(kf[t][kk], qf[kk], acc[t]);
#pragma unroll
                for (int t = 0; t < 4; ++t)
#pragma unroll
                    for (int r = 0; r < 4; ++r) { const int s_idx = 16 * (4 * g4 + t) + 4 * q + r; acc[t][r] = (s_idx <= j) ? fexp(fminf(a4[t][r] - Mj, 0.f)) * acc[t][r] * qscale : 0.f; }
            }
#pragma unroll
            for (int h = 0; h < 2; ++h) { v4u pw; pw.x = pk2(acc[2 * h][0], acc[2 * h][1]); pw.y = pk2(acc[2 * h][2], acc[2 * h][3]); pw.z = pk2(acc[2 * h + 1][0], acc[2 * h + 1][1]); pw.w = pk2(acc[2 * h + 1][2], acc[2 * h + 1][3]);
                pf[2 * g4 + h] = __builtin_bit_cast(bf16x8, pw); }
        }
        f32x4 nv[ET];
#pragma unroll
        for (int et = 0; et < ET; ++et) {
            f32x4 intra = (f32x4){0.f, 0.f, 0.f, 0.f}, inter = (f32x4){0.f, 0.f, 0.f, 0.f};
            s16x4 t0[4], t1[4]; bf16x8 cf[4];
#pragma unroll
            for (int kk = 0; kk < 4; ++kk) {
                LAS unsigned char* vp = lds + OFF_V + (32 * kk + 4 * q + (l15 >> 2)) * PVB + (16 * et + 4 * (lane & 3)) * 2;
                t0[kk] = trrd(vp); t1[kk] = trrd(vp + 16 * PVB);
                cf[kk] = *(LAS bf16x8*)(lds + OFF_C + (16 * et + l15) * PQB + (32 * kk + 8 * q) * 2);
            }
#pragma unroll
            for (int kk = 0; kk < 4; ++kk) {
                const bf16x8 vf = (bf16x8){t0[kk][0], t0[kk][1], t0[kk][2], t0[kk][3], t1[kk][0], t1[kk][1], t1[kk][2], t1[kk][3]};
                intra = MFMA16(vf, pf[kk], intra);
                inter = MFMA16(cf[kk], qf[kk], inter);
            }
            nv[et] = intra + inter * winter;
        }
        {
            const float den = __shfl(nv[ET - 1][0], l15);
            const float inv = 1.0f / fmaxf(fabsf(den), fexp(-mrow));
            bf16* op = hout + (size_t)ROWG(c, j) * DMOD + head * 256 + slice * W + 4 * q;
#pragma unroll
            for (int et = 0; et < ET - 1; ++et) { v2u o; o.x = pk2(nv[et][0] * inv, nv[et][1] * inv); o.y = pk2(nv[et][2] * inv, nv[et][3] * inv); *(v2u*)(op + 16 * et) = o; }
        }
        }
        {
            const float decay = fexp(m_prev - M_last);
#pragma unroll
            for (int et = 0; et < ET; ++et) Cacc[et] = Cacc[et] * decay;
#pragma unroll
            for (int kk = 0; kk < 4; ++kk) {
                LAS unsigned char* kp = lds + OFF_K + (32 * kk + 8 * q + (l15 >> 2)) * PQB + (16 * w + 4 * (lane & 3)) * 2;
                const s16x4 k0 = trrd(kp), k1 = trrd(kp + 4 * PQB);
                const f32x4 w0 = *(LAS f32x4*)(swk + 32 * kk + 8 * q), w1 = *(LAS f32x4*)(swk + 32 * kk + 8 * q + 4);
                v4u kw;
                kw.x = pk2(bf1((unsigned short)k0[0]) * w0[0], bf1((unsigned short)k0[1]) * w0[1]); kw.y = pk2(bf1((unsigned short)k0[2]) * w0[2], bf1((unsigned short)k0[3]) * w0[3]);
                kw.z = pk2(bf1((unsigned short)k1[0]) * w1[0], bf1((unsigned short)k1[1]) * w1[1]); kw.w = pk2(bf1((unsigned short)k1[2]) * w1[2], bf1((unsigned short)k1[3]) * w1[3]);
                const bf16x8 kt = __builtin_bit_cast(bf16x8, kw);
                s16x4 u0[ET], u1[ET];
#pragma unroll
                for (int et = 0; et < ET; ++et) {
                    LAS unsigned char* vp = lds + OFF_V + (32 * kk + 8 * q + (l15 >> 2)) * PVB + (16 * et + 4 * (lane & 3)) * 2;
                    u0[et] = trrd(vp); u1[et] = trrd(vp + 4 * PVB);
                }
#pragma unroll
                for (int et = 0; et < ET; ++et) {
                    const bf16x8 vf = (bf16x8){u0[et][0], u0[et][1], u0[et][2], u0[et][3], u1[et][0], u1[et][1], u1[et][2], u1[et][3]};
                    Cacc[et] = MFMA16(kt, vf, Cacc[et]);
                }
            }
        }
        MBAR();
        if constexpr (!SO) {
#pragma unroll
        for (int et = 0; et < ET; ++et) { v2u o; o.x = pk2(Cacc[et][0], Cacc[et][1]); o.y = pk2(Cacc[et][2], Cacc[et][3]);
            *(LAS v2u*)(lds + OFF_C + (16 * et + l15) * PQB + (16 * w + 4 * q) * 2) = o; }
        }
    }
    if constexpr (SO) {
#pragma unroll
        for (int e = 0; e < ET; ++e)
#pragma unroll
            for (int r = 0; r < 4; ++r) st_save[(e * 4 + r) * 512 + tid] = Cacc[e][r];
        if (tid == 0) { st_save[10240] = m_old; st_save[10241] = bsum; }
    }
    __syncthreads();
#undef MLOAD
#undef GLOAD
#undef SCAN
}

#define XB_TMO      128
#define XB_XCNT(j)  (256  + 64 * (j))
#define XB_XSUB(j)  (1280 + 64 * (j))
#define XB_XGEN(j)  (2304 + 64 * (j))
#define XB_TOP      3328
#define XB_TOPGEN   3392
#define XCD_BAR_WORDS 3456
#define XB_SPIN_CAP (1u << 18)

__device__ __forceinline__ unsigned xb_ld(unsigned* p)              { return __hip_atomic_load(p, __ATOMIC_RELAXED, __HIP_MEMORY_SCOPE_AGENT); }
__device__ __forceinline__ unsigned xb_add(unsigned* p, unsigned v) { return __hip_atomic_fetch_add(p, v, __ATOMIC_RELAXED, __HIP_MEMORY_SCOPE_AGENT); }
__device__ __forceinline__ unsigned xb_xcc_id() { return (unsigned)__builtin_amdgcn_s_getreg((3 << 11) | 20) & 0xFu; }
#define XB_SPIN(cond, bar) do { unsigned _sp = 0; while (cond) { __builtin_amdgcn_s_sleep(1); \
    if ((++_sp & 255u) == 0u) { if (xb_ld(&(bar)[XB_TMO])) break; if (_sp > XB_SPIN_CAP) { atomicAdd(&(bar)[XB_TMO], 1u); break; } } } } while (0)

struct XcdBarrier {
    unsigned* bar; unsigned x;
    volatile LAS unsigned* st;
};

__device__ __forceinline__ XcdBarrier xcd_barrier_post(unsigned* bar, volatile LAS unsigned* st) {
    XcdBarrier b; b.bar = bar; b.x = xb_xcc_id(); b.st = st;
    if (threadIdx.x == 0) (void)xb_add(&bar[XB_XCNT(b.x)], 1u);
    return b;
}
__device__ __forceinline__ void xcd_barrier_complete(unsigned* bar, unsigned x, unsigned& nloc, unsigned& nx) {
    const unsigned G = gridDim.x * gridDim.y * gridDim.z;
    unsigned sum, cnt, mine, sp = 0u;
    for (;;) {
        sum = 0u; cnt = 0u; mine = 0u;
#pragma unroll
        for (unsigned j = 0; j < 16; ++j) { const unsigned c = xb_ld(&bar[XB_XCNT(j)]); sum += c; cnt += (c > 0u) ? 1u : 0u; mine = (j == x) ? c : mine; }
        if (sum == G) break;
        __builtin_amdgcn_s_sleep(1);
        if ((++sp & 255u) == 0u) { if (xb_ld(&bar[XB_TMO])) break; if (sp > XB_SPIN_CAP) { atomicAdd(&bar[XB_TMO], 1u); break; } }
    }
    nloc = mine > 0u ? mine : 1u; nx = cnt > 0u ? cnt : 1u;
}

__device__ __forceinline__ void xcd_barrier(const XcdBarrier& b) {
    asm volatile("s_waitcnt vmcnt(0)" ::: "memory");
    __syncthreads();
    if (threadIdx.x == 0) {
        unsigned* bar = b.bar;
        __builtin_amdgcn_s_waitcnt(0);
        unsigned nloc = b.st[0], nx = b.st[1];
        if (nloc == 0u) { xcd_barrier_complete(bar, b.x, nloc, nx); b.st[0] = nloc; b.st[1] = nx; }
        const unsigned old = xb_add(&bar[XB_XSUB(b.x)], 1u);
        const unsigned gen = old / nloc;
        if (old + 1u == (gen + 1u) * nloc) {
            __builtin_amdgcn_fence(__ATOMIC_RELEASE, "agent");
            asm volatile("s_waitcnt vmcnt(0)" ::: "memory");
            const unsigned og = xb_add(&bar[XB_TOP], 1u);
            const unsigned tg = og / nx;
            if (og + 1u == (tg + 1u) * nx) xb_add(&bar[XB_TOPGEN], 1u);
            else XB_SPIN(xb_ld(&bar[XB_TOPGEN]) == tg, bar);
            __builtin_amdgcn_fence(__ATOMIC_ACQUIRE, "agent");
            xb_add(&bar[XB_XGEN(b.x)], 1u);
            asm volatile("s_waitcnt vmcnt(0)" ::: "memory");
        } else {
            XB_SPIN(xb_ld(&bar[XB_XGEN(b.x)]) == gen, bar);
            __builtin_amdgcn_fence(__ATOMIC_ACQUIRE, "agent");
            asm volatile("s_waitcnt vmcnt(0)" ::: "memory");
        }
    }
    __syncthreads();
}


template <class T> __device__ __forceinline__ T* opq(T* p) { size_t z = 0; asm volatile("" : "+s"(z)); return (T*)((unsigned char*)p + z); }
#define PTRS unsigned char* ws = opq(args.ws); float* out = opq(args.out); const float* xp = args.in[0]; const float* xs = args.in[1]; \
    bf16* WA = (bf16*)(ws + WS_WA); bf16* WB = (bf16*)(ws + WS_WB); bf16* WU = (bf16*)(ws + WS_WU); bf16* WD = (bf16*)(ws + WS_WD); bf16* XN = (bf16*)(ws + WS_XN); bf16* BIG = (bf16*)(ws + WS_BIG); \
    float* ST = (float*)(ws + WS_ST); bf16* HF = (bf16*)out; bf16* HB = HF + (size_t)T_TOK * DMOD; float* SS1 = (float*)(ws + WS_SS); float* SS2 = SS1 + T_TOK; float* SS3 = SS2 + T_TOK; float* SS0 = SS3 + T_TOK; (void)SS0; \
    bf16* W2A = (bf16*)(ws + WS_W2A); bf16* W2B = (bf16*)(ws + WS_W2B); \
    (void)xp; (void)xs; (void)WA; (void)WB; (void)WU; (void)WD; (void)XN; (void)BIG; (void)ST; (void)HF; (void)HB; (void)SS1; (void)SS2; (void)SS3; (void)W2A; (void)W2B
template <int N, int K, int LDA, class Epi>
__device__ __forceinline__ void run_gemm(LAS unsigned char* lds, const bf16* A, const bf16* Bt, const Epi E, int G, int bx) {
    pg8::Gemm g{A, Bt, T_TOK, N, K, LDA}; pg8::StaticOrder S; S.init(T_TOK, N, G, bx);
    pg8::gemm_phase<Epi, pg8::StaticOrder, PG8_ALIGN, PG8_SP2>(lds, g, S, E);
}
struct Args { const float* in[14]; float* out; unsigned char* ws; int ph_lo, ph_hi; };
__global__ void __launch_bounds__(NWAVES * 64, 2) mk_fwd(Args args) {
    extern __shared__ __attribute__((aligned(16))) unsigned char lds_raw[];
    cg::grid_group grid = cg::this_grid();
    LAS unsigned char* lds = (LAS unsigned char*)lds_raw;
    const int tid = threadIdx.x, lane = tid & 63, wave = __builtin_amdgcn_readfirstlane(tid >> 6);
    const int G = gridDim.x, bx = blockIdx.x, vcu = (G % 8 == 0) ? (bx % 8) * (G / 8) + bx / 8 : bx;
    const int gw = bx * NWAVES + wave, NGW = G * NWAVES;
    LAS float* scr = (LAS float*)(lds + wave * 16384);
    volatile LAS unsigned* bst = (volatile LAS unsigned*)(lds + LDS_BYTES - 64);
    if (tid == 0) { bst[0] = 0u; bst[1] = 0u; }
    __syncthreads();
    (void)xcd_barrier_post((unsigned*)args.ws, bst);

    const int lo = args.ph_lo, hi = args.ph_hi;
#define IN(k) (lo <= (k) && (k) < hi)
#define SEAM(k) do { if (IN(k) && IN((k) + 1)) { if (lo < 0) grid.sync(); else { XcdBarrier xb_; xb_.bar = (unsigned*)opq(args.ws); xb_.x = xb_xcc_id(); xb_.st = bst; xcd_barrier(xb_); } } } while (0)
    if (IN(PH_PRE0)) { PTRS;
        convert_weights(args.in[4], DMOD, N_IN, WA, scr, gw, NGW, lane, args.in[2], true);
        for (int i = gw * 64 + lane; i < 4096; i += NGW * 64) { const float ang = (float)(i >> 4) * powf(10000.f, -(float)(2 * (i & 15)) * (1.f / 32.f)); float* tb = (float*)(ws + WS_TAB); tb[i] = cosf(ang); tb[4096 + i] = sinf(ang); }
        for (int m = gw; m < T_TOK; m += NGW) { const float* xr = (m < NPROMPT) ? xp + (size_t)m * DMOD : xs + (size_t)(m - NPROMPT) * DMOD; cvt_row(xr, XN + (size_t)m * DMOD, SS0 + m, lane); }
    }
    SEAM(PH_PRE0);
    if (IN(PH_INPROJ)) { PTRS; run_gemm<3072, DMOD, DMOD, pg8::EpiBf16<0>>(lds, XN, WA, pg8::EpiBf16<0>{BIG, N_IN_PAD, nullptr, 0, 0, 1.f, SS0}, G, bx);
        {
            const bf16* Wg = WA + (size_t)3072 * DMOD;
            const int l15g = lane & 15, qg = lane >> 4;
            for (int blk = gw; blk < T_TOK / 16; blk += NGW) {
                const int r0 = blk * 16;
                f32x4 ga = (f32x4){0.f, 0.f, 0.f, 0.f};
                const bf16* ap = XN + (size_t)(r0 + l15g) * DMOD + 8 * qg;
                const bf16* bp = Wg + (size_t)l15g * DMOD + 8 * qg;
#pragma unroll 8
                for (int sk = 0; sk < 32; ++sk) { const bf16x8 av = *(const bf16x8*)(ap + 32 * sk); const bf16x8 bv = *(const bf16x8*)(bp + 32 * sk); ga = MFMA16(av, bv, ga); }
#pragma unroll
                for (int r = 0; r < 4; ++r) { const int row = r0 + 4 * qg + r;
                    const float rs = 1.0f / sqrtf(SS0[row] * (1.0f / 1024.0f) + 1e-6f);
                    BIG[(size_t)row * N_IN_PAD + 3072 + l15g] = (bf16)(pk2(ga[r] * rs, 0.f) & 0xffffu); }
            }
        }
    }
    SEAM(PH_INPROJ);
#ifndef SKIP_MLSTM
    if (IN(PH_MA)) { PTRS;
        for (int it = vcu; it < 608; it += G) {
            int ci, seg, slice = it & 3;
            if (it < 384) { ci = it / 12; seg = (it >> 2) % 3; } else { const int i2 = it - 384; ci = 32 + i2 / 28; seg = (i2 >> 2) % 7; }
            const bool smp = ci >= 32; const int cc = smp ? ci - 32 : ci;
            const int head = smp ? (cc >> 1) : ((cc >> 1) & 3), dir = cc & 1, rowbase = smp ? NPROMPT : (cc >> 3) * 8192, L = smp ? 16384 : 8192;
            mlstm_item<64, true>(lds, BIG, nullptr, args.in[5], rowbase, L, head, dir, slice, seg * 16, seg * 16 + 16, ST + (size_t)((ci * 8 + seg) * 4 + slice) * ST_SLOT, nullptr, 0);
        }
            {
            int first = 608 - 2 * G; if (first < 0 || first >= G) first = 0;
            if (vcu >= first) { const int gw2 = (vcu - first) * NWAVES + wave, NGW2 = (G - first) * NWAVES;
                convert_weights(args.in[7], DMOD, DMOD, WB, scr, gw2, NGW2, lane);
                convert_weights(args.in[12], DMOD, FF, WU, scr, gw2, NGW2, lane, args.in[3], true); convert_weights(args.in[13], FF, DMOD, WD, scr, gw2, NGW2, lane);
                convert_weights(args.in[8], DMOD, NQKV, W2A, scr, gw2, NGW2, lane, args.in[2] + DMOD, true); convert_weights(args.in[11], DMOD, DMOD, W2B, scr, gw2, NGW2, lane); }
        }
    }
    SEAM(PH_MA);
    if (IN(PH_MB)) { PTRS;
        for (int it = vcu; it < 768; it += G) {
            int ci, seg, slice = it & 3;
            if (it < 512) { ci = it >> 4; seg = (it >> 2) & 3; } else { const int i2 = it - 512; ci = 32 + (i2 >> 5); seg = (i2 >> 2) & 7; }
            const bool smp = ci >= 32; const int cc = smp ? ci - 32 : ci;
            const int head = smp ? (cc >> 1) : ((cc >> 1) & 3), dir = cc & 1, rowbase = smp ? NPROMPT : (cc >> 3) * 8192, L = smp ? 16384 : 8192;
            mlstm_item<64, false>(lds, BIG, dir ? HB : HF, args.in[5], rowbase, L, head, dir, slice, seg * 16, seg * 16 + 16, nullptr, ST + (size_t)((ci * 8) * 4 + slice) * ST_SLOT, seg);
        }
    }
#endif
    SEAM(PH_MB);
#ifndef SKIP_GATE
    if (IN(PH_GATE)) { PTRS;
            const float* gh = args.in[6];
            for (int m = gw; m < T_TOK; m += NGW) {
                v4u f[2], b_[2], o_[2];
#pragma unroll
                for (int h2 = 0; h2 < 2; ++h2) { const int c0 = 512 * h2 + 8 * lane;
                    f[h2] = *(const v4u*)(HF + (size_t)m * DMOD + c0); b_[h2] = *(const v4u*)(HB + (size_t)m * DMOD + c0); o_[h2] = *(const v4u*)(BIG + (size_t)m * N_IN_PAD + 2048 + c0); }
#pragma unroll
                for (int h2 = 0; h2 < 2; ++h2) { const int c0 = 512 * h2 + 8 * lane;
                    float hs[8], og[8];
#pragma unroll
                    for (int i = 0; i < 4; ++i) { hs[2 * i] = bflo(f[h2][i]) + bflo(b_[h2][i]); hs[2 * i + 1] = bfhi(f[h2][i]) + bfhi(b_[h2][i]); og[2 * i] = bflo(o_[h2][i]); og[2 * i + 1] = bfhi(o_[h2][i]); }
                    float s = 0.f;
#pragma unroll
                    for (int i = 0; i < 8; ++i) s += hs[i] * hs[i];
                    s += __shfl_xor(s, 1); s += __shfl_xor(s, 2); s += __shfl_xor(s, 4); s += __shfl_xor(s, 8); s += __shfl_xor(s, 16);
                    const float r = 1.0f / sqrtf(s * (1.f / 256.f) + EPS);
                    const f32x4 g0 = *(const f32x4*)(gh + c0), g1 = *(const f32x4*)(gh + c0 + 4);
                    float y[8];
#pragma unroll
                    for (int i = 0; i < 4; ++i) { y[i] = hs[i] * r * g0[i] / (1.0f + fexp(-og[i])); y[4 + i] = hs[4 + i] * r * g1[i] / (1.0f + fexp(-og[4 + i])); }
                    v4u yo; yo.x = pk2(y[0], y[1]); yo.y = pk2(y[2], y[3]); yo.z = pk2(y[4], y[5]); yo.w = pk2(y[6], y[7]);
                    *(v4u*)(BIG + (size_t)m * N_IN_PAD + c0) = yo;
                }
            }
    }
#endif
    SEAM(PH_GATE);
    if (IN(PH_OUTPROJ)) { PTRS; run_gemm<DMOD, DMOD, N_IN_PAD, EpiRes<1>>(lds, BIG, WB, EpiRes<1>{nullptr, nullptr, 0, nullptr, DMOD, XN, SS1}, G, bx); }
    SEAM(PH_OUTPROJ);
    if (IN(PH_UP0)) { PTRS; run_gemm<FF, DMOD, DMOD, pg8::EpiBf16<2>>(lds, XN, WU, pg8::EpiBf16<2>{BIG, FF, nullptr, 0, 0, 1.f, nullptr}, G, bx); }
    SEAM(PH_UP0);
    if (IN(PH_DOWN0)) { PTRS; run_gemm<DMOD, FF, FF, EpiRes<1>>(lds, BIG, WD, EpiRes<1>{nullptr, SS1, 0, nullptr, DMOD, XN, SS2}, G, bx); }
    SEAM(PH_DOWN0);
    if (IN(PH_QKV)) { PTRS; run_gemm<NQKV, DMOD, DMOD, EpiQKV>(lds, XN, W2A, EpiQKV{BIG, SS2, args.in[9], args.in[10], (const float*)(ws + WS_TAB)}, G, bx);
        {
            const int nun = (T_TOK / 256) * (NQKV / 256); int first = nun % G; if (first == 0) first = 0;
            const int nconv = G - first;
            if (bx >= first) { const int gw2 = (bx - first) * NWAVES + wave, NGW2 = nconv * NWAVES;
                convert_weights(args.in[12] + (size_t)DMOD * FF, DMOD, FF, WU, scr, gw2, NGW2, lane, args.in[3] + DMOD, true); convert_weights(args.in[13] + (size_t)DMOD * FF, FF, DMOD, WD, scr, gw2, NGW2, lane); }
        }
    }
    SEAM(PH_QKV);
#ifndef SKIP_ATTN
    if (IN(PH_ATTN)) { PTRS;
            const attn_body::bf16* Qp = (const attn_body::bf16*)BIG; const attn_body::bf16* Kp = Qp + 1024; const attn_body::bf16* Vp = Qp + 1280; attn_body::bf16* Op = (attn_body::bf16*)BIG;
            float gqm = fabsf(args.in[9][lane]), gkm = fabsf(args.in[10][lane]);
#pragma unroll
            for (int o = 1; o < 64; o <<= 1) { gqm = fmaxf(gqm, __shfl_xor(gqm, o)); gkm = fmaxf(gkm, __shfl_xor(gkm, o)); }
            const float mref = 8.0f * gqm * gkm * 1.4426950408889634f * 1.03f + 0.25f;
            if (G == 256) {
                if (vcu < 128) {
                    const int seq = vcu >> 5, cl = vcu & 31;
                    for (int i = 0; i < 16; ++i) attn_body::attn_unit<8>(mref, (long)seq * 8192, 8192, 4 * (i >> 2) + (cl & 3), 4 * (cl >> 2) + (i & 3), Qp, Kp, Vp, Op, (char*)lds_raw); }
                else { const int v = vcu - 128, head = v >> 3, qb0 = (v & 7) * 8;
                    for (int i = 0; i < 8; ++i) attn_body::attn_unit<8>(mref, (long)NPROMPT, 16384, head, qb0 + i, Qp, Kp, Vp, Op, (char*)lds_raw); }
            } else {
                for (int u = vcu; u < 3072; u += G) {
                    if (u < 2048) attn_body::attn_unit<8>(mref, (long)(u >> 9) * 8192, 8192, (u >> 5) & 15, u & 31, Qp, Kp, Vp, Op, (char*)lds_raw);
                    else { const int u2 = u - 2048; attn_body::attn_unit<8>(mref, (long)NPROMPT, 16384, u2 >> 6, u2 & 63, Qp, Kp, Vp, Op, (char*)lds_raw); }
                }
            }
    }
#endif
    SEAM(PH_ATTN);
    if (IN(PH_OPROJ)) { PTRS; run_gemm<DMOD, DMOD, NQKV, EpiRes<1>>(lds, BIG, W2B, EpiRes<1>{nullptr, nullptr, 0, nullptr, DMOD, XN, SS3}, G, bx); }
    SEAM(PH_OPROJ);
    if (IN(PH_UP1)) { PTRS; run_gemm<FF, DMOD, DMOD, pg8::EpiBf16<2>>(lds, XN, WU, pg8::EpiBf16<2>{BIG, FF, nullptr, 0, 0, 1.f, nullptr}, G, bx); }
    SEAM(PH_UP1);
    if (IN(PH_DOWN1)) { PTRS; run_gemm<DMOD, FF, FF, EpiRes<2>>(lds, BIG, WD, EpiRes<2>{nullptr, SS3, 0, out, DMOD, XN, nullptr}, G, bx); }
#undef IN
#undef SEAM
}

extern "C" void kernel_launch(void* const* d_in, const int* in_sizes, int n_in, void* d_out, int out_size, void* d_ws, size_t ws_size, hipStream_t stream) {
    static int grid = 0;
    if (grid == 0) {
        if (n_in != 14 || out_size != T_TOK * DMOD || ws_size < WS_END) { fprintf(stderr, "kernel_launch: unexpected shapes: n_in %d out %d ws %zu (need %zu)\n", n_in, out_size, ws_size, (size_t)WS_END); grid = -1; return; }
        int dev = 0, cus = 0, per_cu = 0;
        if (hipGetDevice(&dev) != hipSuccess || hipDeviceGetAttribute(&cus, hipDeviceAttributeMultiprocessorCount, dev) != hipSuccess) { grid = -1; return; }
        if (hipFuncSetAttribute((const void*)mk_fwd, hipFuncAttributeMaxDynamicSharedMemorySize, LDS_BYTES) != hipSuccess) { fprintf(stderr, "kernel_launch: hipFuncSetAttribute failed\n"); grid = -1; return; }
        if (hipOccupancyMaxActiveBlocksPerMultiprocessor(&per_cu, (const void*)mk_fwd, NWAVES * 64, LDS_BYTES) != hipSuccess || per_cu < 1) per_cu = 1;
        (void)hipGetLastError();
        grid = cus * per_cu;
    }
    if (grid < 0) return;
    if (hipMemsetAsync(d_ws, 0, CTL_ZERO_BYTES, stream) != hipSuccess) { fprintf(stderr, "kernel_launch: memset of the barrier words failed\n"); return; }
    Args a{};
    for (int i = 0; i < 14; ++i) a.in[i] = (const float*)d_in[i];
    a.out = (float*)d_out; a.ws = (unsigned char*)d_ws;
#if MK_N_LAUNCHES == 1
    a.ph_lo = 0; a.ph_hi = NPHASE;
    void* kargs[] = {&a};
    hipError_t e = hipLaunchCooperativeKernel((const void*)mk_fwd, dim3(grid), dim3(NWAVES * 64), kargs, LDS_BYTES, stream);
    if (e != hipSuccess) fprintf(stderr, "cooperative launch failed: %s (grid %d)\n", hipGetErrorString(e), grid);
#else
    for (int ph = 0; ph < NPHASE; ++ph) {
        a.ph_lo = ph; a.ph_hi = ph + 1;
        hipLaunchKernelGGL(mk_fwd, dim3(grid), dim3(NWAVES * 64), LDS_BYTES, stream, a);
#ifdef PROBE_MASK
        if ((PROBE_MASK >> ph) & 1) hipLaunchKernelGGL(mk_fwd, dim3(grid), dim3(NWAVES * 64), LDS_BYTES, stream, a);
#endif
    }
#endif
}
```

```cpp
#include <hip/hip_runtime.h>
#include <hip/hip_cooperative_groups.h>
#include <cstdio>
#include <cstdint>
#include <hip/hip_bf16.h>
#include <cmath>
namespace cg = cooperative_groups;
namespace pg8 {
#define PG8_LAS __attribute__((address_space(3)))
typedef unsigned short bf16_t;
typedef short bf16x8 __attribute__((ext_vector_type(8)));
typedef float f32x4 __attribute__((ext_vector_type(4)));
typedef unsigned u32x4 __attribute__((ext_vector_type(4)));
constexpr int BM = 256, BK = 64, HALF = 128, HTB = HALF * BK * 2  , STAGE_BYTES = 8 * HTB, NXCD = 8, WGM = 8;

__host__ __device__ __forceinline__ int lds_byte(int r, int c) { const int st = (r >> 4) * 2 + (c >> 5), rr = r & 15, cc = c & 31, ob = rr * 64 + cc * 2; return st * 1024 + (ob ^ (((ob >> 9) & 1) << 5)); }
__host__ __device__ __forceinline__ void stage_rc(int b, int& R, int& C) { const int st = b / 1024, sb = b % 1024, swz = sb ^ (((sb >> 9) & 1) << 5); R = (st >> 1) * 16 + swz / 64; C = (st & 1) * 32 + (swz % 64) / 2; }
__host__ __device__ __forceinline__ int perm32(int rho) { const int n = rho >> 4, i = rho & 15; return 8 * (i >> 2) + 4 * n + (i & 3); }

struct Unit { int pm, pn; };
struct Gemm { const bf16_t* A; const bf16_t* Bt; int M, N, K, lda; };

struct StaticOrder {
    int nM, nN, nwg, G, c;
    __host__ __device__ void init(int M, int N, int G_, int c_) { nM = M / BM; nN = N / BM; nwg = nM * nN; G = G_; c = c_; }
    __host__ __device__ bool next(int i, Unit& u) const {
        const long L = (long)i * G + c; if (L >= nwg) return false;
        int wgid = (int)L; { const int q = nwg / NXCD, r = nwg % NXCD, xcd = wgid % NXCD, off = wgid / NXCD; wgid = (xcd < r ? xcd * (q + 1) : r * (q + 1) + (xcd - r) * q) + off; }
        const int nig = WGM * nN, gid = wgid / nig, fm = gid * WGM, gsz = (nM - fm) < WGM ? (nM - fm) : WGM;
        u.pm = fm + ((wgid % nig) % gsz); u.pn = (wgid % nig) / gsz; return true;
    }
    __device__ __forceinline__ void a_ready(const Unit&) const {}
    __device__ __forceinline__ void done(const Unit&) const {}
};

__device__ __forceinline__ unsigned cvt_pk_bf16(float lo, float hi) { unsigned r; asm volatile("v_cvt_pk_bf16_f32 %0, %1, %2" : "=v"(r) : "v"(lo), "v"(hi)); return r; }
typedef float f32x2 __attribute__((ext_vector_type(2)));
__device__ __forceinline__ f32x2 gelu_pk(f32x2 v) {
    const f32x2 av = __builtin_elementwise_abs(v), d = av * 0.2316418882f + 1.0f;
    f32x2 t; t.x = __builtin_amdgcn_rcpf(d.x); t.y = __builtin_amdgcn_rcpf(d.y);
    f32x2 q = t * 0.5307027145f + (-0.7265760135f); q = q * t + 0.7107068705f; q = q * t + (-0.142248368f); q = q * t + 0.127414796f; q = q * t;
    const f32x2 s = (v * v) * (-0.72134752044f);
    f32x2 e; e.x = __builtin_amdgcn_exp2f(s.x); e.y = __builtin_amdgcn_exp2f(s.y);
    const f32x2 m = v * (q * e), r = v - m;
    f32x2 o; o.x = v.x < 0.f ? m.x : r.x; o.y = v.y < 0.f ? m.y : r.y; return o;
}

template <int ACT  > struct EpiBf16 {
    static constexpr bool PERM = true, AFTER_DRAIN = false; static_assert(ACT == 0 || ACT == 2, "EpiBf16: ACT is 0 (none) or 2 (squared relu)");
    bf16_t* O; int ldc; const float* bias; int split_cols; size_t split_stride; float scale0; const float* ss;
    __device__ __forceinline__ void operator()(const f32x4 (&acc)[2][2][4][2], const Unit& u, int wr, int wc, int fr, int fq) const {
        const bool lo = fr < 8;
        bf16_t* cbase = O + u.pn * BM + 64 * wc + 8 * fq;
        float rsv[2][4];
#pragma unroll
        for (int ai = 0; ai < 2; ++ai)
#pragma unroll
            for (int m = 0; m < 4; ++m) rsv[ai][m] = ss ? ss[u.pm * BM + wr * 64 + ai * HALF + m * 16 + fr] : 1.0f;
#pragma unroll
        for (int ai = 0; ai < 2; ++ai)
#pragma unroll
            for (int m = 0; m < 4; ++m) rsv[ai][m] = ss ? 1.0f / sqrtf(rsv[ai][m] * (1.0f / 1024.0f) + 1e-6f) : 1.0f;
#pragma unroll
        for (int ai = 0; ai < 2; ++ai)
#pragma unroll
            for (int m = 0; m < 4; ++m) {
                const int rbase = u.pm * BM + wr * 64 + ai * HALF + m * 16;
                const float rs = rsv[ai][m];
                u32x4 w[2];
#pragma unroll
                for (int bj = 0; bj < 2; ++bj) { f32x4 v0 = acc[ai][bj][m][0] * rs, v1 = acc[ai][bj][m][1] * rs;
                    if (ACT == 2) { _Pragma("unroll") for (int q_ = 0; q_ < 4; ++q_) { const float a_ = fmaxf(v0[q_], 0.f), b_ = fmaxf(v1[q_], 0.f); v0[q_] = a_ * a_; v1[q_] = b_ * b_; } }
                    w[bj].x = cvt_pk_bf16(v0[0], v0[1]); w[bj].y = cvt_pk_bf16(v0[2], v0[3]); w[bj].z = cvt_pk_bf16(v1[0], v1[1]); w[bj].w = cvt_pk_bf16(v1[2], v1[3]); }
                u32x4 bx;
#pragma unroll
                for (int k = 0; k < 4; ++k) bx[k] = (unsigned)__builtin_amdgcn_update_dpp(0, (int)w[1][k], 0x128, 0xf, 0xf, false);
                const u32x4 s1 = lo ? w[0] : bx, s2 = lo ? bx : w[0];
                bf16_t* p1 = cbase + (size_t)(rbase + (fr & 7)) * ldc + (lo ? 0 : 32);
                bf16_t* p2 = cbase + (size_t)(rbase + 8 + (fr & 7)) * ldc + (lo ? 32 : 0);
                if (ACT == 2) { __builtin_nontemporal_store(s1, (u32x4*)p1); __builtin_nontemporal_store(s2, (u32x4*)p2); }
                else { *(u32x4*)p1 = s1; *(u32x4*)p2 = s2; }
            }
    }
};

template <class Epi, class Sched, bool ALIGN_EPI = false, bool SP2 = false>
__device__ __forceinline__ void gemm_phase(PG8_LAS unsigned char* lds, const Gemm g, const Sched& S, const Epi& E) {
    const int tid = threadIdx.x, wid = __builtin_amdgcn_readfirstlane(tid >> 6), lane = tid & 63, wr = wid >> 2, wc = wid & 3, fr = lane & 15, fq = lane >> 4;
    const int K = g.K, nt = K / BK;
    unsigned voffA[2], voffB[2];
#pragma unroll
    for (int i = 0; i < 2; ++i) { int R, C; stage_rc(tid * 16 + i * 8192, R, C); const int Rb = Epi::PERM ? ((R & ~31) + perm32(R & 31)) : R;
        voffA[i] = (unsigned)(R * g.lda + C) * 2u; voffB[i] = (unsigned)(Rb * K + C) * 2u; }
    const size_t kstep = (size_t)(BK * 2);
    const size_t hstep = (size_t)HALF * K * 2;
    const size_t tstep = 2 * hstep;
    const size_t hstepA = (size_t)HALF * g.lda * 2, tstepA = 2 * hstepA;
    const unsigned ldsw = (unsigned)wid * 1024u;
    const int aoff = lds_byte(wr * 64 + fr, fq * 8), boff = lds_byte(wc * 32 + fr, fq * 8);
#define PG8_SA(b, h) (((b) * 2 + (h)) * HTB)
#define PG8_SB(b, h) ((4 + (b) * 2 + (h)) * HTB)
#define PG8_STAGE(bufoff, gbase, voff) do { _Pragma("unroll") for (int _i = 0; _i < 2; ++_i) \
        __builtin_amdgcn_global_load_lds((const unsigned*)((const char*)(gbase) + (voff)[_i]), (PG8_LAS unsigned*)(lds + (bufoff) + ldsw + _i * 8192), 16, 0, 0); } while (0)
#define PG8_LDA(dst, b, h) do { _Pragma("unroll") for (int m = 0; m < 4; ++m) _Pragma("unroll") for (int k = 0; k < 2; ++k) dst[m][k] = *(const PG8_LAS bf16x8*)(lds + PG8_SA(b, h) + aoff + m * 2048 + k * 1024); } while (0)
#define PG8_LDB(dst, b, h) do { _Pragma("unroll") for (int n = 0; n < 2; ++n) _Pragma("unroll") for (int k = 0; k < 2; ++k) dst[n][k] = *(const PG8_LAS bf16x8*)(lds + PG8_SB(b, h) + boff + n * 2048 + k * 1024); } while (0)
#define PG8_MMA(ai, bj, At, Bt) do { __builtin_amdgcn_s_setprio(1); _Pragma("unroll") for (int m = 0; m < 4; ++m) _Pragma("unroll") for (int n = 0; n < 2; ++n) _Pragma("unroll") for (int k = 0; k < 2; ++k) \
        acc[ai][bj][m][n] = __builtin_amdgcn_mfma_f32_16x16x32_bf16(Bt[n][k], At[m][k], acc[ai][bj][m][n], 0, 0, 0); __builtin_amdgcn_s_setprio(0); } while (0)
#define PG8_WAIT_V(n) asm volatile("s_waitcnt vmcnt(" #n ")" ::: "memory")
#define PG8_WAIT_L(n) asm volatile("s_waitcnt lgkmcnt(" #n ")" ::: "memory")
#define PG8_BAR __builtin_amdgcn_s_barrier()
#define PG8_SCHED __builtin_amdgcn_sched_barrier(0)
    Unit cur, nxt; int ui = 0;
    if (!S.next(0, cur)) return;
    f32x4 acc[2][2][4][2];
#pragma unroll
    for (int a = 0; a < 2; ++a)
#pragma unroll
        for (int b = 0; b < 2; ++b)
#pragma unroll
            for (int m = 0; m < 4; ++m)
#pragma unroll
                for (int n = 0; n < 2; ++n) acc[a][b][m][n] = (f32x4){0.f, 0.f, 0.f, 0.f};
    bf16x8 At[4][2], B0[2][2], B1[2][2];
    const char* cA = (const char*)g.A + (size_t)cur.pm * tstepA; const char* cB = (const char*)g.Bt + (size_t)cur.pn * tstep;
    S.a_ready(cur);
    if constexpr (SP2) {
        PG8_STAGE(PG8_SB(0, 0), cB, voffB); PG8_STAGE(PG8_SB(0, 1), cB + hstep, voffB); PG8_STAGE(PG8_SA(0, 0), cA, voffA); PG8_STAGE(PG8_SA(0, 1), cA + hstepA, voffA);
        if (wr == 1) PG8_BAR;
        PG8_WAIT_V(2); PG8_BAR;
        PG8_STAGE(PG8_SB(1, 0), cB + kstep, voffB); PG8_STAGE(PG8_SA(1, 0), cA + kstep, voffA); PG8_STAGE(PG8_SB(1, 1), cB + hstep + kstep, voffB);
        PG8_WAIT_V(6); PG8_BAR;
    } else {
        PG8_STAGE(PG8_SB(0, 0), cB, voffB); PG8_STAGE(PG8_SA(0, 0), cA, voffA); PG8_STAGE(PG8_SB(0, 1), cB + hstep, voffB); PG8_STAGE(PG8_SA(0, 1), cA + hstepA, voffA);
        if (wr == 1) PG8_BAR;
        PG8_WAIT_V(4); PG8_BAR;
        PG8_STAGE(PG8_SB(1, 0), cB + kstep, voffB); PG8_STAGE(PG8_SA(1, 0), cA + kstep, voffA); PG8_STAGE(PG8_SB(1, 1), cB + hstep + kstep, voffB);
        PG8_WAIT_V(6); PG8_BAR;
    }
    for (;;) {
        const bool has_next = S.next(ui + 1, nxt);
        const char* nA = has_next ? (const char*)g.A + (size_t)nxt.pm * tstepA : cA; const char* nB = has_next ? (const char*)g.Bt + (size_t)nxt.pn * tstep : cB;
        for (int t = 0; t < nt; t += 2) {
            const bool last = (t == nt - 2);
            const char* a1 = cA + (size_t)(t + 1) * kstep;
            const char* a2 = last ? nA : cA + (size_t)(t + 2) * kstep; const char* b2 = last ? nB : cB + (size_t)(t + 2) * kstep;
            const char* a3 = a2 + kstep; const char* b3 = b2 + kstep;
            if (last && has_next) S.a_ready(nxt);
            if constexpr (SP2) {
            PG8_LDB(B0, 0, 0); PG8_LDB(B1, 0, 1); PG8_SCHED; PG8_LDA(At, 0, 0); PG8_STAGE(PG8_SA(1, 1), a1 + hstepA, voffA);
            PG8_WAIT_V(8); PG8_WAIT_L(0); PG8_BAR; PG8_MMA(0, 0, At, B0); PG8_MMA(0, 1, At, B1); PG8_BAR; PG8_SCHED;
            PG8_LDA(At, 0, 1); PG8_STAGE(PG8_SB(0, 0), b2, voffB); PG8_STAGE(PG8_SB(0, 1), b2 + hstep, voffB); PG8_STAGE(PG8_SA(0, 0), a2, voffA);
            PG8_WAIT_V(8); PG8_WAIT_L(0); PG8_BAR; PG8_MMA(1, 0, At, B0); PG8_MMA(1, 1, At, B1); PG8_BAR; PG8_SCHED;
            PG8_LDB(B0, 1, 0); PG8_LDB(B1, 1, 1); PG8_SCHED; PG8_LDA(At, 1, 0); PG8_STAGE(PG8_SA(0, 1), a2 + hstepA, voffA);
            PG8_WAIT_V(8); PG8_WAIT_L(0); PG8_BAR; PG8_MMA(0, 0, At, B0); PG8_MMA(0, 1, At, B1); PG8_BAR; PG8_SCHED;
            PG8_LDA(At, 1, 1); PG8_STAGE(PG8_SB(1, 0), b3, voffB); PG8_STAGE(PG8_SB(1, 1), b3 + hstep, voffB); PG8_STAGE(PG8_SA(1, 0), a3, voffA);
            PG8_WAIT_V(8); PG8_WAIT_L(0); PG8_BAR; PG8_MMA(1, 0, At, B0); PG8_MMA(1, 1, At, B1); PG8_BAR; PG8_SCHED;
            } else {
            PG8_LDB(B0, 0, 0); PG8_SCHED; PG8_LDA(At, 0, 0); PG8_STAGE(PG8_SA(1, 1), a1 + hstepA, voffA);
            PG8_WAIT_L(8); PG8_BAR; PG8_WAIT_L(0); PG8_MMA(0, 0, At, B0); PG8_BAR; PG8_SCHED;
            PG8_LDB(B1, 0, 1); PG8_STAGE(PG8_SB(0, 0), b2, voffB);
            PG8_BAR; PG8_WAIT_L(0); PG8_MMA(0, 1, At, B1); PG8_BAR;
            PG8_LDA(At, 0, 1); PG8_STAGE(PG8_SA(0, 0), a2, voffA);
            PG8_BAR; PG8_WAIT_L(0); PG8_MMA(1, 0, At, B0); PG8_BAR; PG8_SCHED;
            PG8_STAGE(PG8_SB(0, 1), b2 + hstep, voffB);
            PG8_WAIT_V(6); PG8_BAR; PG8_MMA(1, 1, At, B1); PG8_BAR;
            PG8_LDB(B0, 1, 0); PG8_SCHED; PG8_LDA(At, 1, 0); PG8_STAGE(PG8_SA(0, 1), a2 + hstepA, voffA);
            PG8_WAIT_L(8); PG8_BAR; PG8_WAIT_L(0); PG8_MMA(0, 0, At, B0); PG8_BAR; PG8_SCHED;
            PG8_LDB(B1, 1, 1); PG8_STAGE(PG8_SB(1, 0), b3, voffB);
            PG8_BAR; PG8_WAIT_L(0); PG8_MMA(0, 1, At, B1); PG8_BAR;
            PG8_LDA(At, 1, 1); PG8_STAGE(PG8_SA(1, 0), a3, voffA);
            PG8_BAR; PG8_WAIT_L(0); PG8_MMA(1, 0, At, B0); PG8_BAR; PG8_SCHED;
            PG8_STAGE(PG8_SB(1, 1), b3 + hstep, voffB);
            PG8_WAIT_V(6); PG8_BAR; PG8_MMA(1, 1, At, B1); PG8_BAR;
            }
        }
        if constexpr (ALIGN_EPI) { if (wr == 0) PG8_BAR; }
        if constexpr (!Epi::AFTER_DRAIN) { E(acc, cur, wr, wc, fr, fq); S.done(cur); }
        if (!has_next) break;
#pragma unroll
        for (int a = 0; a < 2; ++a)
#pragma unroll
            for (int b = 0; b < 2; ++b)
#pragma unroll
                for (int m = 0; m < 4; ++m)
#pragma unroll
                    for (int n = 0; n < 2; ++n) acc[a][b][m][n] = (f32x4){0.f, 0.f, 0.f, 0.f};
        cur = nxt; cA = nA; cB = nB; ++ui;
        if constexpr (ALIGN_EPI) { if (wr == 1) PG8_BAR; }
    }
    PG8_WAIT_V(0);
    if constexpr (!ALIGN_EPI) { if (wr == 0) PG8_BAR; }
    PG8_BAR;
    if constexpr (Epi::AFTER_DRAIN) { E.fused(acc, cur, wr, wc, fr, fq, lds, wid, lane); S.done(cur); }
#undef PG8_SA
#undef PG8_SB
#undef PG8_STAGE
#undef PG8_LDA
#undef PG8_LDB
#undef PG8_MMA
#undef PG8_WAIT_V
#undef PG8_WAIT_L
#undef PG8_BAR
#undef PG8_SCHED
}
}

#ifndef PG8_SP2
#define PG8_SP2 true
#endif
#ifndef PG8_ALIGN
#define PG8_ALIGN true
#endif
namespace attn_body {
using bf16=__hip_bfloat16;
using bf16x8=__attribute__((ext_vector_type(8)))short;
using s16x4=__attribute__((ext_vector_type(4)))short;
using f32x16=__attribute__((ext_vector_type(16)))float;
using u32x4=__attribute__((ext_vector_type(4)))unsigned;
constexpr int NHEAD=16,D=64,DM=1536,OPITCH=1536,GQ=4;
constexpr int NW=8,QBLK=32,QB=QBLK*NW,KVBLK=64;
constexpr int ATTN_PITCH=DM, ATTN_UNIT_ROWS=QB;
__device__ __forceinline__ int crow(int r,int hi){return (r&3)+8*(r>>2)+4*hi;}
#define SBAR() __builtin_amdgcn_sched_barrier(0)
__device__ __forceinline__ void cmask(f32x16&p0,f32x16&p1,int jb,int qrel,int hi){
  const float NEG=-INFINITY; int kb=64*jb+4*hi;
  #pragma unroll
  for(int r=0;r<16;++r){int kv=kb+(r&3)+8*(r>>2); if(kv>qrel)p0[r]=NEG; if(kv+32>qrel)p1[r]=NEG;}
}

constexpr int NSLOT=3, SLOTB=8192;
constexpr int LDS_K=0, LDS_V=NSLOT*SLOTB, LDS_WS=2*NSLOT*SLOTB, LDS_OST=LDS_WS+NW*64*4, LDS_BYTES=LDS_OST+NW*4096;
constexpr float C2=0.125f*1.4426950408889634f;
__device__ __forceinline__ void glds16(const void*gsrc,unsigned lds_dst){unsigned keep;
  asm volatile("s_mov_b32 %0, m0\n\ts_mov_b32 m0, %2\n\ts_nop 0\n\tglobal_load_lds_dwordx4 %1, off\n\ts_mov_b32 m0, %0":"=&s"(keep):"v"(gsrc),"s"(lds_dst):"memory");}
__device__ __forceinline__ float max3f(float a,float b,float c){float r;asm("v_max3_f32 %0, %1, %2, %3":"=v"(r):"v"(a),"v"(b),"v"(c));return r;}
__device__ __forceinline__ float max2f(float a,float b){float r;asm("v_max_f32_e32 %0, %1, %2":"=v"(r):"v"(a),"v"(b));return r;}
__device__ __forceinline__ float fadd_s(float a,float b){float r;asm("v_add_f32_e32 %0, %1, %2":"=v"(r):"v"(a),"v"(b));return r;}
__device__ __forceinline__ float fsub_s(float a,float b){float r;asm("v_sub_f32_e32 %0, %1, %2":"=v"(r):"v"(a),"v"(b));return r;}
typedef float f32x2_t __attribute__((ext_vector_type(2))); typedef __bf16 bf16x2_t __attribute__((ext_vector_type(2)));
__device__ __forceinline__ unsigned cvtpk_s(float lo,float hi){f32x2_t v={lo,hi};bf16x2_t b=__builtin_convertvector(v,bf16x2_t);return __builtin_bit_cast(unsigned,b);}
#define WAIT_BAR(N) asm volatile("s_waitcnt vmcnt(" #N ") lgkmcnt(0)\n\ts_barrier":::"memory")

__device__ __forceinline__ void qkt(f32x16&p0,f32x16&p1,const char*Kslot,const bf16x8*qr,const f32x16&negm,int r32,int hi){
  const char*kb=Kslot+hi*1024+r32*16;
  #pragma unroll
  for(int d0=0;d0<4;++d0){
    const bf16x8 b0=*reinterpret_cast<const bf16x8*>(kb+d0*2048);
    const bf16x8 b1=*reinterpret_cast<const bf16x8*>(kb+d0*2048+512);
    if(d0==0){p0=__builtin_amdgcn_mfma_f32_32x32x16_bf16(b0,qr[0],negm,0,0,0);p1=__builtin_amdgcn_mfma_f32_32x32x16_bf16(b1,qr[0],negm,0,0,0);}
    else{p0=__builtin_amdgcn_mfma_f32_32x32x16_bf16(b0,qr[d0],p0,0,0,0);p1=__builtin_amdgcn_mfma_f32_32x32x16_bf16(b1,qr[d0],p1,0,0,0);}}
}
typedef __attribute__((address_space(3))) const char* lds_cptr;
typedef short v4i16_t __attribute__((ext_vector_type(4)));
__device__ __forceinline__ void kload8(bf16x8*kf,lds_cptr kp){
  kf[0]=*(const __attribute__((address_space(3))) bf16x8*)(kp);      kf[1]=*(const __attribute__((address_space(3))) bf16x8*)(kp+512);
  kf[2]=*(const __attribute__((address_space(3))) bf16x8*)(kp+2048); kf[3]=*(const __attribute__((address_space(3))) bf16x8*)(kp+2560);
  kf[4]=*(const __attribute__((address_space(3))) bf16x8*)(kp+4096); kf[5]=*(const __attribute__((address_space(3))) bf16x8*)(kp+4608);
  kf[6]=*(const __attribute__((address_space(3))) bf16x8*)(kp+6144); kf[7]=*(const __attribute__((address_space(3))) bf16x8*)(kp+6656);
}
__device__ __forceinline__ void kload2(bf16x8*kf,lds_cptr kp,int j){ kf[2*j]=*(const __attribute__((address_space(3))) bf16x8*)(kp+j*2048); kf[2*j+1]=*(const __attribute__((address_space(3))) bf16x8*)(kp+j*2048+512); }
__device__ __forceinline__ s16x4 vtr(lds_cptr p){ return __builtin_bit_cast(s16x4,__builtin_amdgcn_ds_read_tr16_b64_v4i16((__attribute__((address_space(3))) v4i16_t*)p)); }
__device__ __forceinline__ float rowmax(const f32x16&p0,const f32x16&p1){
  float a=max3f(p0[0],p0[1],p1[0]),b=max3f(p0[2],p0[3],p1[1]);a=max3f(a,p1[2],p1[3]);
  #pragma unroll
  for(int r=4;r<16;r+=4){a=max3f(a,p0[r],p0[r+1]);b=max3f(b,p0[r+2],p0[r+3]);a=max3f(a,p1[r],p1[r+1]);b=max3f(b,p1[r+2],p1[r+3]);}
  const float m=max2f(a,b);
  auto rr=__builtin_amdgcn_permlane32_swap(__float_as_uint(m),__float_as_uint(m),false,false);
  return max2f(__uint_as_float(rr[0]),__uint_as_float(rr[1]));
}
__device__ __forceinline__ void pv(f32x16*o,int vb,bf16x8 pa0,bf16x8 pa1,bf16x8 pa2,bf16x8 pa3){
  #pragma unroll
  for(int d0=0;d0<2;++d0){s16x4 lo[4],hi[4];
    #pragma unroll
    for(int ks=0;ks<4;++ks){
      asm volatile("ds_read_b64_tr_b16 %0,%1 offset:%c2":"=&v"(lo[ks]):"v"(vb),"i"(d0*4096+ks*1024):"memory");
      asm volatile("ds_read_b64_tr_b16 %0,%1 offset:%c2":"=&v"(hi[ks]):"v"(vb),"i"(d0*4096+ks*1024+512):"memory");}
    asm volatile("s_waitcnt lgkmcnt(0)":::"memory");SBAR();
    #define PK(k) (bf16x8){lo[k][0],lo[k][1],lo[k][2],lo[k][3],hi[k][0],hi[k][1],hi[k][2],hi[k][3]}
    o[d0]=__builtin_amdgcn_mfma_f32_32x32x16_bf16(pa0,PK(0),o[d0],0,0,0);
    o[d0]=__builtin_amdgcn_mfma_f32_32x32x16_bf16(pa1,PK(1),o[d0],0,0,0);
    o[d0]=__builtin_amdgcn_mfma_f32_32x32x16_bf16(pa2,PK(2),o[d0],0,0,0);
    o[d0]=__builtin_amdgcn_mfma_f32_32x32x16_bf16(pa3,PK(3),o[d0],0,0,0);
    #undef PK
  }
}

#ifndef ATTN_STORE16
#define ATTN_STORE16(p,v) (*(u32x4*)(p)=(v))
#endif
template<int THRL> __device__ __forceinline__ void attn_unit(const float mref,long rowbase,int SEQ,int h,int qb,const bf16*Q,const bf16*__restrict__ K,const bf16*__restrict__ V,bf16*O,char*shm){
  const int tid=threadIdx.x,lane=tid&63,r32=lane&31,hi=lane>>5; const int wid=__builtin_amdgcn_readfirstlane(tid>>6);
  const int q0=qb*QB;
  const bf16*Qw=Q+(rowbase+q0+wid*QBLK)*DM+h*D;
  const bf16*Kh=K+rowbase*DM+(h/GQ)*D,*Vh=V+rowbase*DM+(h/GQ)*D;
  const unsigned lds0=(unsigned)(uintptr_t)shm;
  float*wsf=(float*)(shm+LDS_WS)+wid*64;
  const bf16*ksrc=Kh+(long)lane*DM+wid*8;
  const bf16*vsrc=Vh+(long)(16*(wid&3)+(lane>>2))*DM+(wid>>2)*32+(lane&3)*8;
  const unsigned kdst=lds0+LDS_K+wid*1024, vdst=lds0+LDS_V+wid*1024;
  #define DMA_K(t,slot) glds16(ksrc+(long)(t)*KVBLK*DM,(unsigned)__builtin_amdgcn_readfirstlane(kdst+(slot)))
  #define DMA_V(t,slot) glds16(vsrc+(long)(t)*KVBLK*DM,(unsigned)__builtin_amdgcn_readfirstlane(vdst+(slot)))
  const int vb0=(int)(lds0+LDS_V)+((lane>>4)&1)*32+(lane&3)*8+(4*hi+((lane&15)>>2))*64;
  const char*Kbase=shm+LDS_K; bf16x8 kf[8];
  const lds_cptr shm3=(lds_cptr)shm; const lds_cptr kp0=shm3+LDS_K+hi*1024+r32*16; const lds_cptr vp0=shm3+LDS_V+((lane>>4)&1)*32+(lane&3)*8+(4*hi+((lane&15)>>2))*64;
  if(wid>=4)__builtin_amdgcn_s_setprio(1);
  const int NT=SEQ/KVBLK;
  DMA_K(0,0);DMA_V(0,0);DMA_K(1,SLOTB);
  bf16x8 qr[4];
  #pragma unroll
  for(int d0=0;d0<4;++d0)qr[d0]=*reinterpret_cast<const bf16x8*>(&Qw[(long)r32*DM+d0*16+hi*8]);
  float mhat=0.f,l_reg=0.f;f32x16 o[2];o[0]=f32x16{};o[1]=f32x16{};f32x16 negm=f32x16{};asm volatile("":"+v"(negm));

  #define CMASK(P0,P1,t) do{}while(0)
  bool resc=false;
  #define START(P0,P1) do{ const float rm=mref; resc=false; \
    { const float dl=rm; mhat=fadd_s(mhat,dl); \
      _Pragma("unroll") for(int r=0;r<16;++r){P0[r]=fsub_s(P0[r],dl);P1[r]=fsub_s(P1[r],dl);} \
      _Pragma("unroll") for(int r=0;r<16;++r)negm[r]=-mhat; asm volatile("":"+v"(negm)); } \
    _Pragma("unroll") for(int r=0;r<16;++r)P0[r]=__builtin_amdgcn_exp2f(P0[r]); }while(0)
  #define RESC() do{ if(resc){ asm volatile("s_waitcnt lgkmcnt(0)":::"memory"); \
      _Pragma("unroll") for(int d_=0;d_<2;++d_) _Pragma("unroll") for(int r=0;r<16;++r)o[d_][r]*=wsf[crow(r,hi)]; } }while(0)
  f32x16 pA0,pA1,pB0,pB1;
  int sl_prev=0,sl_cur=0,sl_next=SLOTB;
  #define ROT() do{sl_prev=sl_cur;sl_cur=sl_next;sl_next=(sl_next==(NSLOT-1)*SLOTB)?0:sl_next+SLOTB;}while(0)
  DMA_K(2,2*SLOTB);
  WAIT_BAR(3);
  qkt(pA0,pA1,Kbase,qr,negm,r32,hi);asm volatile("s_nop 15\n\ts_nop 7":"+v"(pA0),"+v"(pA1));CMASK(pA0,pA1,0);
  START(pA0,pA1);
  _Pragma("unroll") for(int r=0;r<16;++r)pA1[r]=__builtin_amdgcn_exp2f(pA1[r]);
  WAIT_BAR(0);
  DMA_K(3,0);DMA_V(1,SLOTB);
  ROT();
  kload8(kf,kp0+sl_cur);
  WAIT_BAR(2);
  s16x4 vlo[8],vhi[8]; u32x4 pw0,pw1,pw2,pw3;
  #define PKW(P,B) cvtpk_s(P[B],P[B+1])
  #define PAF(k) __builtin_bit_cast(bf16x8,pw##k)
  #define VFR(i) (bf16x8){vlo[i][0],vlo[i][1],vlo[i][2],vlo[i][3],vhi[i][0],vhi[i][1],vhi[i][2],vhi[i][3]}
  #define PIN(x) asm volatile("":"+v"(x))
  #define MX3(a,b,c) __builtin_fmaxf(__builtin_fmaxf((a),(b)),(c))
  #define GAPA(MF,A0,A1,A2,A3,W0,W1,PW) do{ MF; sacc+=A0; sacc+=A1; sacc+=A2; sacc+=A3; PIN(sacc); W0; W1; PIN(PW); SBAR(); }while(0)
  #define EX(v) __builtin_amdgcn_exp2f(v)
  #define GAPB(MF,X,B) do{ MF; X[B]=EX(X[B]); X[B+1]=EX(X[B+1]); X[B+2]=EX(X[B+2]); X[B+3]=EX(X[B+3]); PIN(X); SBAR(); }while(0)
  #define VRD(i) do{ vlo[i]=vtr(vp_+(((i)>>2)*4096+((i)&3)*1024)); vhi[i]=vtr(vp_+(((i)>>2)*4096+((i)&3)*1024+512)); }while(0)
  #define KRD(G,j) do{ if(G){ kload2(kf,kp0+sl_next,j); SBAR(); } }while(0)
  #define STEP(C0,C1,P0,P1,t,GK,GV,GL) do{ SBAR(); \
    const lds_cptr vp_=vp0+sl_prev; \
    VRD(0); SBAR(); float sacc=(P0[0]+P0[1]); \
    GAPA(C0=__builtin_amdgcn_mfma_f32_32x32x16_bf16(kf[0],qr[0],negm,0,0,0), P0[2],P0[3],P0[4],P0[5],     pw0[0]=PKW(P0,0), pw0[1]=PKW(P0,2), pw0); \
    VRD(4); SBAR(); GAPA(C1=__builtin_amdgcn_mfma_f32_32x32x16_bf16(kf[1],qr[0],negm,0,0,0), P0[6],P0[7],P0[8],P0[9],     pw0[2]=PKW(P0,4), pw0[3]=PKW(P0,6), pw0); \
    VRD(1); SBAR(); GAPA(C0=__builtin_amdgcn_mfma_f32_32x32x16_bf16(kf[2],qr[1],C0,0,0,0),   P0[10],P0[11],P0[12],P0[13], pw1[0]=PKW(P0,8), pw1[1]=PKW(P0,10), pw1); \
    VRD(5); SBAR(); GAPA(C1=__builtin_amdgcn_mfma_f32_32x32x16_bf16(kf[3],qr[1],C1,0,0,0),   P0[14],P0[15],P1[0],P1[1],   pw1[2]=PKW(P0,12),pw1[3]=PKW(P0,14), pw1); \
    VRD(2); SBAR(); GAPA(C0=__builtin_amdgcn_mfma_f32_32x32x16_bf16(kf[4],qr[2],C0,0,0,0),   P1[2],P1[3],P1[4],P1[5],     pw2[0]=PKW(P1,0), pw2[1]=PKW(P1,2), pw2); \
    VRD(6); SBAR(); GAPA(C1=__builtin_amdgcn_mfma_f32_32x32x16_bf16(kf[5],qr[2],C1,0,0,0),   P1[6],P1[7],P1[8],P1[9],     pw2[2]=PKW(P1,4), pw2[3]=PKW(P1,6), pw2); \
    VRD(3); SBAR(); GAPA(C0=__builtin_amdgcn_mfma_f32_32x32x16_bf16(kf[6],qr[3],C0,0,0,0),   P1[10],P1[11],P1[12],P1[13], pw3[0]=PKW(P1,8), pw3[1]=PKW(P1,10), pw3); \
    VRD(7); SBAR(); GAPA(C1=__builtin_amdgcn_mfma_f32_32x32x16_bf16(kf[7],qr[3],C1,0,0,0),   P1[14],P1[15],0.f,0.f,       pw3[2]=PKW(P1,12),pw3[3]=PKW(P1,14), pw3); \
    l_reg+=sacc; \
    if(GK){DMA_K((t)+3,sl_cur);} if(GV){DMA_V((t)+1,sl_next);} \
    CMASK(C0,C1,t); \
    resc=false;   \
    SBAR(); \
    GAPB(o[0]=__builtin_amdgcn_mfma_f32_32x32x16_bf16(PAF(0),VFR(0),o[0],0,0,0), C0,0); \
    GAPB(o[1]=__builtin_amdgcn_mfma_f32_32x32x16_bf16(PAF(0),VFR(4),o[1],0,0,0), C0,4); \
    KRD(GL,0); GAPB(o[0]=__builtin_amdgcn_mfma_f32_32x32x16_bf16(PAF(1),VFR(1),o[0],0,0,0), C0,8); \
    KRD(GL,1); GAPB(o[1]=__builtin_amdgcn_mfma_f32_32x32x16_bf16(PAF(1),VFR(5),o[1],0,0,0), C0,12); \
    KRD(GL,2); GAPB(o[0]=__builtin_amdgcn_mfma_f32_32x32x16_bf16(PAF(2),VFR(2),o[0],0,0,0), C1,0); \
    KRD(GL,3); GAPB(o[1]=__builtin_amdgcn_mfma_f32_32x32x16_bf16(PAF(2),VFR(6),o[1],0,0,0), C1,4); \
    GAPB(o[0]=__builtin_amdgcn_mfma_f32_32x32x16_bf16(PAF(3),VFR(3),o[0],0,0,0), C1,8); \
    GAPB(o[1]=__builtin_amdgcn_mfma_f32_32x32x16_bf16(PAF(3),VFR(7),o[1],0,0,0), C1,12); \
    }while(0)
  int t=1;
  #undef CMASK
  #define CMASK(P0,P1,t) do{}while(0)
  for(;t+5<NT;t+=2){
    STEP(pB0,pB1,pA0,pA1,t,true,true,true);     WAIT_BAR(2); RESC(); ROT();
    STEP(pA0,pA1,pB0,pB1,t+1,true,true,true);   WAIT_BAR(2); RESC(); ROT();
  }
  #undef CMASK
  #define CMASK(P0,P1,t) do{}while(0)
  #define ENDW(tt) do{ if((tt)+3<NT){WAIT_BAR(2);} else if((tt)+2<NT){WAIT_BAR(1);} else {WAIT_BAR(0);} }while(0)
  for(;t+1<NT;t+=2){
    STEP(pB0,pB1,pA0,pA1,t,(t+3<NT),(t+1<NT),(t+1<NT));       ENDW(t);   RESC(); ROT();
    STEP(pA0,pA1,pB0,pB1,t+1,(t+4<NT),(t+2<NT),(t+2<NT));     ENDW(t+1); RESC(); ROT();
  }
  STEP(pB0,pB1,pA0,pA1,NT-1,false,false,false); RESC();
  { float sacc=pB0[0]+pB0[1]; _Pragma("unroll") for(int r=2;r<16;++r)sacc+=pB0[r]; _Pragma("unroll") for(int r=0;r<16;++r)sacc+=pB1[r]; l_reg+=sacc;
    pw0=(u32x4){PKW(pB0,0),PKW(pB0,2),PKW(pB0,4),PKW(pB0,6)};pw1=(u32x4){PKW(pB0,8),PKW(pB0,10),PKW(pB0,12),PKW(pB0,14)};pw2=(u32x4){PKW(pB1,0),PKW(pB1,2),PKW(pB1,4),PKW(pB1,6)};pw3=(u32x4){PKW(pB1,8),PKW(pB1,10),PKW(pB1,12),PKW(pB1,14)};
    SBAR(); pv(o,vb0+sl_cur,PAF(0),PAF(1),PAF(2),PAF(3)); }
  #undef PKW
  #undef PAF
  #undef VFR
  #undef PIN
  #undef MX3
  #undef GAPA
  #undef GAPB
  #undef EX
  #undef VRD
  #undef KRD
  #undef STEP
  #undef ENDW
  {auto rr=__builtin_amdgcn_permlane32_swap(__float_as_uint(l_reg),__float_as_uint(l_reg),false,false);l_reg=__uint_as_float(rr[0])+__uint_as_float(rr[1]);}
  if(hi==0)wsf[32+r32]=l_reg;asm volatile("s_waitcnt lgkmcnt(0)":::"memory");
  float rli[16];
  #pragma unroll
  for(int r=0;r<16;++r)rli[r]=__builtin_amdgcn_rcpf(wsf[32+crow(r,hi)]);
  bf16*Ow=O+(rowbase+q0+wid*QBLK)*OPITCH+h*D;
  { bf16*stg=(bf16*)(shm+LDS_OST)+wid*2048;
    #pragma unroll
    for(int r=0;r<16;++r){const int orow=crow(r,hi);
      #pragma unroll
      for(int d0=0;d0<2;++d0)stg[orow*64+d0*32+r32]=__float2bfloat16(o[d0][r]*rli[r]);}
    asm volatile("s_waitcnt lgkmcnt(0)":::"memory");
    #pragma unroll
    for(int i=0;i<4;++i){const int row=i*8+(lane>>3),ch=lane&7; const u32x4 v=*(const u32x4*)(stg+row*64+ch*8); ATTN_STORE16(Ow+(long)row*OPITCH+ch*8,v);} }
  __builtin_amdgcn_s_setprio(0);
  asm volatile("s_waitcnt lgkmcnt(0)\n\ts_barrier":::"memory");
  #undef DMA_K
  #undef DMA_V
  #undef CMASK
  #undef START
  #undef RESC
  #undef ROT
}
constexpr int ATTN_LDS_BYTES=LDS_BYTES;
#undef SBAR
#undef WAIT_BAR
}
#define GAS __attribute__((address_space(1)))
#define LAS __attribute__((address_space(3)))
typedef unsigned short bf16;
typedef unsigned v4u __attribute__((ext_vector_type(4)));
typedef unsigned v2u __attribute__((ext_vector_type(2)));
typedef float f32x4 __attribute__((ext_vector_type(4)));
typedef short bf16x8 __attribute__((ext_vector_type(8)));
typedef short s16x4 __attribute__((ext_vector_type(4)));

#ifndef MK_N_LAUNCHES
#define MK_N_LAUNCHES 1
#endif
constexpr int NWAVES = 8;
enum Phase { PH_PRE0 = 0, PH_INPROJ, PH_MA, PH_MB, PH_GATE, PH_OUTPROJ, PH_UP0, PH_DOWN0, PH_QKV, PH_ATTN, PH_OPROJ, PH_UP1, PH_DOWN1, NPHASE };
constexpr int T_TOK = 49152, NPROMPT = 32768, DMOD = 1024, FF = 4096;
constexpr int N_IN = 3088, N_IN_PAD = 3328, NQKV = 1536;
constexpr float EPS = 1e-6f;
constexpr size_t MiB = 1u << 20;
constexpr size_t WS_WA = 1 * MiB, WS_WB = 8 * MiB, WS_WU = 10 * MiB, WS_WD = 18 * MiB, WS_XN = 26 * MiB, WS_BIG = 122 * MiB, WS_ST = 440 * MiB, WS_W2A = 506 * MiB, WS_W2B = 509 * MiB, WS_END = 511 * MiB;
constexpr size_t WS_SS = 65536, WS_TAB = 868352  , CTL_ZERO_BYTES = 1 * MiB;
constexpr int LDS_BYTES = 159744;

__device__ __forceinline__ unsigned f2bf(float f) { unsigned u = __builtin_bit_cast(unsigned, f); return (u + 0x7fffu + ((u >> 16) & 1u)) >> 16; }
typedef float f32x2v_t __attribute__((ext_vector_type(2))); typedef __bf16 bf16x2v_t __attribute__((ext_vector_type(2)));
__device__ __forceinline__ unsigned pk2(float lo, float hi) { f32x2v_t v = {lo, hi}; bf16x2v_t b = __builtin_convertvector(v, bf16x2v_t); return __builtin_bit_cast(unsigned, b); }
__device__ __forceinline__ float bflo(unsigned u) { return __uint_as_float(u << 16); }
__device__ __forceinline__ float bfhi(unsigned u) { return __uint_as_float(u & 0xffff0000u); }
__device__ __forceinline__ float bf1(unsigned short u) { return __uint_as_float(((unsigned)u) << 16); }
__device__ __forceinline__ float wave_sum(float v) {
#pragma unroll
    for (int o = 1; o < 64; o <<= 1) v += __shfl_xor(v, o);
    return v;
}
__device__ __forceinline__ float fexp(float x) { return __builtin_amdgcn_exp2f(x * 1.4426950408889634f); }
__device__ __forceinline__ float flog(float x) { return __builtin_amdgcn_logf(x) * 0.6931471805599453f; }
#define LDS_WAIT() asm volatile("s_waitcnt lgkmcnt(0)" ::: "memory")

template <int MODE> struct EpiRes {
    static constexpr bool PERM = true, AFTER_DRAIN = false;
    const float* base0; const float* base1; int split_row; float* out; int ldc; bf16* xb; float* ss;
    __device__ __forceinline__ void operator()(const pg8::f32x4 (&acc)[2][2][4][2], const pg8::Unit& u, int wr, int wc, int fr, int fq) const {
#pragma unroll
        for (int ai = 0; ai < 2; ++ai) {
            v4u bw[4][2]; f32x4 bf0[4][2], bf1[4][2]; float r2v[4];
#pragma unroll
            for (int m = 0; m < 4; ++m) {
                const int row = u.pm * 256 + ai * 128 + wr * 64 + m * 16 + fr;
                r2v[m] = ((MODE == 1 || MODE == 2) && base1) ? base1[row] : 1.0f;
#pragma unroll
                for (int bj = 0; bj < 2; ++bj) { const int col = u.pn * 256 + bj * 128 + wc * 32 + 8 * fq;
                    if (MODE == 0) { const float* b = (row < split_row) ? base0 + (size_t)row * ldc : base1 + (size_t)(row - split_row) * ldc; bf0[m][bj] = *(const f32x4*)(b + col); bf1[m][bj] = *(const f32x4*)(b + col + 4); }
                    else bw[m][bj] = *(const v4u*)(xb + (size_t)row * ldc + col); }
            }
#pragma unroll
            for (int m = 0; m < 4; ++m) {
                const int row = u.pm * 256 + ai * 128 + wr * 64 + m * 16 + fr;
                float sq = 0.f;
                const float r2 = ((MODE == 1 || MODE == 2) && base1) ? 1.0f / (r2v[m] * (1.0f / 1024.0f) + 1e-6f) : 1.0f;
#pragma unroll
                for (int bj = 0; bj < 2; ++bj) {
                    const int col = u.pn * 256 + bj * 128 + wc * 32 + 8 * fq;
                    f32x4 v0, v1;
                    if (MODE == 0) { v0 = bf0[m][bj]; v1 = bf1[m][bj]; }
                    else { const v4u w_ = bw[m][bj]; v0 = (f32x4){bflo(w_.x), bfhi(w_.x), bflo(w_.y), bfhi(w_.y)}; v1 = (f32x4){bflo(w_.z), bfhi(w_.z), bflo(w_.w), bfhi(w_.w)}; }
                    v0 = v0 + acc[ai][bj][m][0] * r2; v1 = v1 + acc[ai][bj][m][1] * r2;
                    if (MODE == 2) { float* o = out + (size_t)row * ldc + col; __builtin_nontemporal_store(v0, (f32x4*)o); __builtin_nontemporal_store(v1, (f32x4*)(o + 4)); }
                    else {
                        v4u w; w.x = pk2(v0[0], v0[1]); w.y = pk2(v0[2], v0[3]); w.z = pk2(v1[0], v1[1]); w.w = pk2(v1[2], v1[3]);
                        *(v4u*)(xb + (size_t)row * ldc + col) = w;
                        sq += (v0[0] * v0[0] + v0[1] * v0[1]) + (v0[2] * v0[2] + v0[3] * v0[3]) + (v1[0] * v1[0] + v1[1] * v1[1]) + (v1[2] * v1[2] + v1[3] * v1[3]);
                    }
                }
                if (MODE != 2) { sq += __shfl_xor(sq, 16); sq += __shfl_xor(sq, 32); if (fq == 0) atomicAdd(ss + row, sq); }
            }
        }
    }
};

struct EpiQKV {
    static constexpr bool PERM = true, AFTER_DRAIN = false;
    bf16* O; const float* ss; const float* gq; const float* gk; const float* tab;
    __device__ __forceinline__ void operator()(const pg8::f32x4 (&acc)[2][2][4][2], const pg8::Unit& u, int wr, int wc, int fr, int fq) const {
        const int pn = u.pn; const bool rot = pn < 5;
        const float* g = (pn < 4) ? gq : gk;
        f32x4 gg[2][2];
#pragma unroll
        for (int bj = 0; bj < 2; ++bj)
#pragma unroll
            for (int n = 0; n < 2; ++n) gg[bj][n] = *(const f32x4*)(g + 32 * bj + 8 * fq + 4 * n);
        const float osc = (pn < 4) ? attn_body::C2 : 1.f, sgn = (fq & 2) ? 1.f : -1.f;
        const int fo = 8 * (fq & 1);
        float rsv[2][4];
#pragma unroll
        for (int ai = 0; ai < 2; ++ai)
#pragma unroll
            for (int m = 0; m < 4; ++m) rsv[ai][m] = ss[u.pm * 256 + ai * 128 + wr * 64 + m * 16 + fr];
#pragma unroll
        for (int ai = 0; ai < 2; ++ai)
#pragma unroll
            for (int m = 0; m < 4; ++m) {
                const int row = u.pm * 256 + ai * 128 + wr * 64 + m * 16 + fr;
                const float rs = 1.0f / sqrtf(rsv[ai][m] * (1.0f / 1024.0f) + 1e-6f);
                f32x4 x[2][2];
#pragma unroll
                for (int bj = 0; bj < 2; ++bj)
#pragma unroll
                    for (int n = 0; n < 2; ++n) x[bj][n] = acc[ai][bj][m][n] * rs;
                if (rot) {
                    float s = 0.f;
#pragma unroll
                    for (int bj = 0; bj < 2; ++bj)
#pragma unroll
                        for (int n = 0; n < 2; ++n) s += (x[bj][n][0] * x[bj][n][0] + x[bj][n][1] * x[bj][n][1]) + (x[bj][n][2] * x[bj][n][2] + x[bj][n][3] * x[bj][n][3]);
                    s += __shfl_xor(s, 16); s += __shfl_xor(s, 32);
                    const float rh = 1.0f / sqrtf(s * (1.0f / 64.0f) + 1e-6f);
                    const int pos = (row < NPROMPT) ? (row & 8191) : (row - NPROMPT);
#pragma unroll
                    for (int bj = 0; bj < 2; ++bj) {
                        const int pc = bj ? (pos & 63) : (pos >> 6);
                        const float* tc = tab + pc * 16 + fo;
#pragma unroll
                        for (int n = 0; n < 2; ++n) {
                            const f32x4 cs = *(const f32x4*)(tc + 4 * n), sn = *(const f32x4*)(tc + 4096 + 4 * n);
                            f32x4 o;
#pragma unroll
                            for (int r = 0; r < 4; ++r) { const float xn = x[bj][n][r] * rh * gg[bj][n][r]; const float pr = __shfl_xor(xn, 32); o[r] = (xn * cs[r] + sgn * pr * sn[r]) * osc; }
                            x[bj][n] = o;
                        }
                    }
                }
#pragma unroll
                for (int bj = 0; bj < 2; ++bj) {
                    v4u w; w.x = pk2(x[bj][0][0], x[bj][0][1]); w.y = pk2(x[bj][0][2], x[bj][0][3]); w.z = pk2(x[bj][1][0], x[bj][1][1]); w.w = pk2(x[bj][1][2], x[bj][1][3]);
                    *(v4u*)(O + (size_t)row * NQKV + pn * 256 + 64 * wc + 32 * bj + 8 * fq) = w;
                }
            }
    }
};

__device__ __forceinline__ void transpose_item(const float* W, int K, int N, bf16* WT, LAS float* scr, int item, int lane, const float* gk, const bool permq) {
    const int nblk = (N + 31) / 32, kb = item / nblk, nb = item % nblk, k0 = 64 * kb, n0 = 32 * nb;
    const int nn = n0 + (lane & 31);
#pragma unroll 8
    for (int i = 0; i < 32; ++i) { const int kk = 2 * i + (lane >> 5); scr[kk * 33 + (lane & 31)] = (nn < N) ? W[(size_t)(k0 + kk) * N + nn] * (gk ? gk[k0 + kk] : 1.f) : 0.f; }
    LDS_WAIT(); asm volatile("" ::: "memory");
    const int c = lane & 7;
#pragma unroll
    for (int j = 0; j < 4; ++j) { const int n = (lane >> 3) + 8 * j; const LAS float* s = scr + (8 * c) * 33 + n;
        v4u o; o.x = pk2(s[0 * 33], s[1 * 33]); o.y = pk2(s[2 * 33], s[3 * 33]); o.z = pk2(s[4 * 33], s[5 * 33]); o.w = pk2(s[6 * 33], s[7 * 33]);
        const int cq = n0 + n, rowo = permq ? ((cq & ~255) + 128 * ((cq >> 5) & 1) + 32 * ((cq >> 6) & 3) + (cq & 31)) : cq;
        *(v4u*)(WT + (size_t)rowo * K + k0 + 8 * c) = o; }
    LDS_WAIT(); asm volatile("" ::: "memory");
}
__device__ __forceinline__ void convert_weights(const float* W, int K, int N, bf16* WT, LAS float* scr, int gw, int NGW, int lane, const float* gk = nullptr, const bool permq = false) {
    const int items = (K / 64) * ((N + 31) / 32);
    for (int it = gw; it < items; it += NGW) transpose_item(W, K, N, WT, scr, it, lane, gk, permq);
}
__device__ __forceinline__ void cvt_row(const float* xrow, bf16* orow, float* ssq, int lane) {
    const f32x4* xr = (const f32x4*)xrow + lane;
    f32x4 v[4]; float s = 0.f;
#pragma unroll
    for (int j = 0; j < 4; ++j) { v[j] = __builtin_nontemporal_load(xr + 64 * j); s += (v[j].x * v[j].x + v[j].y * v[j].y) + (v[j].z * v[j].z + v[j].w * v[j].w); }
    s = wave_sum(s);
    unsigned long long* o8 = (unsigned long long*)orow + lane;
#pragma unroll
    for (int j = 0; j < 4; ++j) o8[64 * j] = (unsigned long long)pk2(v[j].x, v[j].y) | ((unsigned long long)pk2(v[j].z, v[j].w) << 32);
    if (lane == 0) *ssq = s;
}

__device__ __forceinline__ s16x4 trrd(LAS unsigned char* p) { return __builtin_bit_cast(s16x4, __builtin_amdgcn_ds_read_tr16_b64_v4i16((LAS s16x4*)p)); }
#define MFMA16(a, b, c) __builtin_amdgcn_mfma_f32_16x16x32_bf16((a), (b), (c), 0, 0, 0)
#define ROWG(c_, j_) (rowbase + (dir ? (L - 1 - ((c_) * 128 + (j_))) : ((c_) * 128 + (j_))))
constexpr int ST_SLOT = 10304;
#define DPPF(old, x, ctrl, rm) __builtin_bit_cast(float, __builtin_amdgcn_update_dpp(__builtin_bit_cast(int, (float)(old)), __builtin_bit_cast(int, (float)(x)), (ctrl), (rm), 0xf, false))
#define MBAR() asm volatile("s_waitcnt lgkmcnt(0)\n\ts_barrier" ::: "memory")
template <int W, bool SO>
__device__ __forceinline__ void mlstm_item(LAS unsigned char* lds, const bf16* __restrict__ proj, bf16* __restrict__ hout, const float* __restrict__ bgate,
                                           const int rowbase, const int L, const int head, const int dir, const int slice,
                                           const int cbeg, const int cend, float* st_save, const float* st_prev, const int nprev) {
    constexpr int ET = W / 16 + 1, PQB = 288, PVB = (W + 16 + 8) * 2, VCH = W / 8, NVR = W / 32;
    constexpr int OFF_Q = 0, OFF_K = 36864, OFF_P = 73728  , OFF_V = 110592, OFF_C = OFF_V + 22528, OFF_G = OFF_C + 23040;
    static_assert(OFF_G + 2304 <= LDS_BYTES - 64, "mlstm LDS map");
    static_assert(ET * 4 * 512 + 2 <= ST_SLOT, "state slot");
    const int tid = threadIdx.x, lane = tid & 63, w = __builtin_amdgcn_readfirstlane(tid >> 6), l15 = lane & 15, q = lane >> 4;
    const float qscale = 0.08838834764831845f;
    const float bg_i = bgate[dir * 8 + head], bg_f = bgate[dir * 8 + 4 + head];
    for (int i = tid; i < 128 * 16; i += 512) { const int r = i >> 4, cc = i & 15; *(LAS bf16*)(lds + OFF_V + r * PVB + (W + cc) * 2) = (cc == 0) ? (bf16)0x3F80 : (bf16)0; }
    f32x4 Cacc[ET];
#pragma unroll
    for (int e = 0; e < ET; ++e) Cacc[e] = (f32x4){0.f, 0.f, 0.f, 0.f};
    float m_old = -1e30f, bsum = 0.f;
    if constexpr (!SO) {
        for (int sg = 0; sg < nprev; ++sg) {
            const float* p = st_prev + (size_t)sg * 4 * ST_SLOT;
            const float ms = p[10240], Bs = p[10241];
            const float mn = fmaxf(Bs + m_old, ms), f1 = fexp(Bs + m_old - mn), f2 = fexp(ms - mn);
#pragma unroll
            for (int e = 0; e < ET; ++e)
#pragma unroll
                for (int r = 0; r < 4; ++r) Cacc[e][r] = f1 * Cacc[e][r] + f2 * p[(e * 4 + r) * 512 + tid];
            m_old = mn;
        }
#pragma unroll
        for (int et = 0; et < ET; ++et) { v2u o; o.x = pk2(Cacc[et][0], Cacc[et][1]); o.y = pk2(Cacc[et][2], Cacc[et][3]);
            *(LAS v2u*)(lds + OFF_C + (16 * et + l15) * PQB + (16 * w + 4 * q) * 2) = o; }
    }
    v4u rq[4], rk[4], rv[NVR]; unsigned short gl[2], gf[2];
#define MLOAD(c_) do { \
    _Pragma("unroll") for (int i_ = 0; i_ < 4; ++i_) { const int id_ = tid + 512 * i_, r_ = id_ >> 4, ch_ = id_ & 15; \
        const bf16* src_ = proj + (size_t)ROWG(c_, r_) * N_IN_PAD + head * 128 + ch_ * 8; if constexpr (!SO) rq[i_] = *(const v4u*)src_; rk[i_] = *(const v4u*)(src_ + 512); } \
    _Pragma("unroll") for (int i_ = 0; i_ < NVR; ++i_) { const int id_ = tid + 512 * i_, r_ = id_ / VCH, ch_ = id_ % VCH; \
        rv[i_] = *(const v4u*)(proj + (size_t)ROWG(c_, r_) * N_IN_PAD + 1024 + head * 256 + slice * W + ch_ * 8); } \
  } while (0)
#define GLOAD(c_) do { _Pragma("unroll") for (int e_ = 0; e_ < 2; ++e_) { const bf16* g_ = proj + (size_t)ROWG(c_, 2 * lane + e_) * N_IN_PAD + 3072 + dir * 8 + head; gl[e_] = g_[0]; gf[e_] = g_[4]; } } while (0)
#define SCAN(par_) do { LAS float* sa_ = (LAS float*)(lds + OFF_P + (par_) * 2304); LAS float* sM_ = sa_ + 128; LAS float* smr_ = sa_ + 256; LAS float* swk_ = sa_ + 384; LAS float* sc_ = sa_ + 512; \
            const float li0 = bf1(gl[0]) + bg_i, li1 = bf1(gl[1]) + bg_i, f0 = bf1(gf[0]) + bg_f, f1 = bf1(gf[1]) + bg_f; \
            const float lf0 = fminf(f0, 0.f) - flog(1.f + fexp(-fabsf(f0))), lf1 = fminf(f1, 0.f) - flog(1.f + fexp(-fabsf(f1))); \
            const float p = lf0 + lf1; float incl = p; \
            incl += DPPF(0.f, incl, 0x111, 0xf); incl += DPPF(0.f, incl, 0x112, 0xf); incl += DPPF(0.f, incl, 0x114, 0xf); incl += DPPF(0.f, incl, 0x118, 0xf); \
            incl += DPPF(0.f, incl, 0x142, 0xa); incl += DPPF(0.f, incl, 0x143, 0xc); \
            const float b0 = (incl - p) + lf0, b1 = incl; \
            const float a0 = li0 - b0, a1 = li1 - b1; \
            float im = fmaxf(a0, a1); \
            im = fmaxf(im, DPPF(-3e38f, im, 0x111, 0xf)); im = fmaxf(im, DPPF(-3e38f, im, 0x112, 0xf)); im = fmaxf(im, DPPF(-3e38f, im, 0x114, 0xf)); im = fmaxf(im, DPPF(-3e38f, im, 0x118, 0xf)); \
            im = fmaxf(im, DPPF(-3e38f, im, 0x142, 0xa)); im = fmaxf(im, DPPF(-3e38f, im, 0x143, 0xc)); \
            float ex = __shfl_up(im, 1); ex = (lane == 0) ? m_old : fmaxf(ex, m_old); \
            const float M0 = fmaxf(ex, a0), M1 = fmaxf(M0, a1); \
            const float M_last = __builtin_bit_cast(float, __builtin_amdgcn_readlane(__builtin_bit_cast(int, M1), 63)), b_last = __builtin_bit_cast(float, __builtin_amdgcn_readlane(__builtin_bit_cast(int, b1), 63)); \
            sa_[2 * lane] = a0; sa_[2 * lane + 1] = a1; sM_[2 * lane] = M0; sM_[2 * lane + 1] = M1; \
            smr_[2 * lane] = b0 + M0; smr_[2 * lane + 1] = b1 + M1; \
            swk_[2 * lane] = fexp(a0 - M_last); swk_[2 * lane + 1] = fexp(a1 - M_last); \
            if (lane == 0) { sc_[0] = M_last; sc_[1] = m_old; } \
            m_old = b_last + M_last; bsum += b_last; \
  } while (0)
    MLOAD(cbeg);
    if (w == 0) { GLOAD(cbeg); SCAN(0); if (cbeg + 1 < cend) GLOAD(cbeg + 1); }
    for (int c = cbeg; c < cend; ++c) {
#pragma unroll
        for (int i = 0; i < 4; ++i) { const int id = tid + 512 * i, r = id >> 4, ch = id & 15;
            if constexpr (!SO) *(LAS v4u*)(lds + OFF_Q + r * PQB + ch * 16) = rq[i];
            *(LAS v4u*)(lds + OFF_K + r * PQB + ch * 16) = rk[i]; }
#pragma unroll
        for (int i = 0; i < NVR; ++i) { const int id = tid + 512 * i, r = id / VCH, ch = id % VCH; *(LAS v4u*)(lds + OFF_V + r * PVB + ch * 16) = rv[i]; }
        MBAR();
        if (c + 1 < cend) MLOAD(c + 1);
        if (w == 0 && c + 1 < cend) { SCAN((c + 1 - cbeg) & 1); if (c + 2 < cend) GLOAD(c + 2); }
        LAS float* sa = (LAS float*)(lds + OFF_P + ((c - cbeg) & 1) * 2304); LAS float* sM = sa + 128; LAS float* smr = sa + 256; LAS float* swk = sa + 384; LAS float* sc = sa + 512;
        (void)sM; (void)smr;
        const float M_last = sc[0], m_prev = sc[1];
        if constexpr (!SO) {
        const int wq = (w < 4) ? w : 11 - w;
        const int j = 16 * wq + l15;
        const float Mj = sM[j], mrow = smr[j];
        const float winter = fexp(m_prev - Mj) * qscale;
        bf16x8 qf[4];
#pragma unroll
        for (int kk = 0; kk < 4; ++kk) qf[kk] = *(LAS bf16x8*)(lds + OFF_Q + j * PQB + (32 * kk + 8 * q) * 2);
        bf16x8 pf[4];
#pragma unroll
        for (int g4 = 0; g4 < 2; ++g4) {
            f32x4 acc[4];
#pragma unroll
            for (int t = 0; t < 4; ++t) acc[t] = (f32x4){0.f, 0.f, 0.f, 0.f};
            if (4 * g4 <= wq) {
                bf16x8 kf[4][4]; f32x4 a4[4];
#pragma unroll
                for (int t = 0; t < 4; ++t) {
#pragma unroll
                    for (int kk = 0; kk < 4; ++kk) kf[t][kk] = *(LAS bf16x8*)(lds + OFF_K + (16 * (4 * g4 + t) + l15) * PQB + (32 * kk + 8 * q) * 2);
                    a4[t] = *(LAS f32x4*)(sa + 16 * (4 * g4 + t) + 4 * q);
                }
#pragma unroll
                for (int kk = 0; kk < 4; ++kk)
#pragma unroll
                    for (int t = 0; t < 4; ++t) acc[t] = MFMA16(kf[t][kk], qf[kk], acc[t]);
#pragma unroll
                for (int t = 0; t < 4; ++t)
#pragma unroll
                    for (int r = 0; r < 4; ++r) { const int s_idx = 16 * (4 * g4 + t) + 4 * q + r; acc[t][r] = (s_idx <= j) ? fexp(fminf(a4[t][r] - Mj, 0.f)) * acc[t][r] * qscale : 0.f; }
            }
#pragma unroll
            for (int h = 0; h < 2; ++h) { v4u pw; pw.x = pk2(acc[2 * h][0], acc[2 * h][1]); pw.y = pk2(acc[2 * h][2], acc[2 * h][3]); pw.z = pk2(acc[2 * h + 1][0], acc[2 * h + 1][1]); pw.w = pk2(acc[2 * h + 1][2], acc[2 * h + 1][3]);
                pf[2 * g4 + h] = __builtin_bit_cast(bf16x8, pw); }
        }
        f32x4 nv[ET];
#pragma unroll
        for (int et = 0; et < ET; ++et) {
            f32x4 intra = (f32x4){0.f, 0.f, 0.f, 0.f}, inter = (f32x4){0.f, 0.f, 0.f, 0.f};
            s16x4 t0[4], t1[4]; bf16x8 cf[4];
#pragma unroll
            for (int kk = 0; kk < 4; ++kk) {
                LAS unsigned char* vp = lds + OFF_V + (32 * kk + 4 * q + (l15 >> 2)) * PVB + (16 * et + 4 * (lane & 3)) * 2;
                t0[kk] = trrd(vp); t1[kk] = trrd(vp + 16 * PVB);
                cf[kk] = *(LAS bf16x8*)(lds + OFF_C + (16 * et + l15) * PQB + (32 * kk + 8 * q) * 2);
            }
#pragma unroll
            for (int kk = 0; kk < 4; ++kk) {
                const bf16x8 vf = (bf16x8){t0[kk][0], t0[kk][1], t0[kk][2], t0[kk][3], t1[kk][0], t1[kk][1], t1[kk][2], t1[kk][3]};
                intra = MFMA16(vf, pf[kk], intra);
                inter = MFMA16(cf[kk], qf[kk], inter);
            }
            nv[et] = intra + inter * winter;
        }
        {
            const float den = __shfl(nv[ET - 1][0], l15);
            const float inv = 1.0f / fmaxf(fabsf(den), fexp(-mrow));
            bf16* op = hout + (size_t)ROWG(c, j) * DMOD + head * 256 + slice * W + 4 * q;
#pragma unroll
            for (int et = 0; et < ET - 1; ++et) { v2u o; o.x = pk2(nv[et][0] * inv, nv[et][1] * inv); o.y = pk2(nv[et][2] * inv, nv[et][3] * inv); *(v2u*)(op + 16 * et) = o; }
        }
        }
        {
            const float decay = fexp(m_prev - M_last);
#pragma unroll
            for (int et = 0; et < ET; ++et) Cacc[et] = Cacc[et] * decay;
#pragma unroll
            for (int kk = 0; kk < 4; ++kk) {
                LAS unsigned char* kp = lds + OFF_K + (32 * kk + 8 * q + (l15 >> 2)) * PQB + (16 * w + 4 * (lane & 3)) * 2;
                const s16x4 k0 = trrd(kp), k1 = trrd(kp + 4 * PQB);
                const f32x4 w0 = *(LAS f32x4*)(swk + 32 * kk + 8 * q), w1 = *(LAS f32x4*)(swk + 32 * kk + 8 * q + 4);
                v4u kw;
                kw.x = pk2(bf1((unsigned short)k0[0]) * w0[0], bf1((unsigned short)k0[1]) * w0[1]); kw.y = pk2(bf1((unsigned short)k0[2]) * w0[2], bf1((unsigned short)k0[3]) * w0[3]);
                kw.z = pk2(bf1((unsigned short)k1[0]) * w1[0], bf1((unsigned short)k1[1]) * w1[1]); kw.w = pk2(bf1((unsigned short)k1[2]) * w1[2], bf1((unsigned short)k1[3]) * w1[3]);
                const bf16x8 kt = __builtin_bit_cast(bf16x8, kw);
                s16x4 u0[ET], u1[ET];
#pragma unroll
                for (int et = 0; et < ET; ++et) {
                    LAS unsigned char* vp = lds + OFF_V + (32 * kk + 8 * q + (l15 >> 2)) * PVB + (16 * et + 4 * (lane & 3)) * 2;
                    u0[et] = trrd(vp); u1[et] = trrd(vp + 4 * PVB);
                }
#pragma unroll
                for (int et = 0; et < ET; ++et) {
                    const bf16x8 vf = (bf16x8){u0[et][0], u0[et][1], u0[et][2], u0[et][3], u1[et][0], u1[et][1], u1[et][2], u1[et][3]};
                    Cacc[et] = MFMA16(kt, vf, Cacc[et]);
                }
            }
        }
        MBAR();
        if constexpr (!SO) {
#pragma unroll
        for (int et = 0; et < ET; ++et) { v2u o; o.x = pk2(Cacc[et][0], Cacc[et][1]); o.y = pk2(Cacc[et][2], Cacc[et][3]);
            *(LAS v2u*)(lds + OFF_C + (16 * et + l15) * PQB + (16 * w + 4 * q) * 2) = o; }
        }
    }
    if constexpr (SO) {
#pragma unroll
        for (int e = 0; e < ET; ++e)
#pragma unroll
            for (int r = 0; r < 4; ++r) st_save[(e * 4 + r) * 512 + tid] = Cacc[e][r];
        if (tid == 0) { st_save[10240] = m_old; st_save[10241] = bsum; }
    }
    __syncthreads();
#undef MLOAD
#undef GLOAD
#undef SCAN
}

#define XB_TMO      128
#define XB_XCNT(j)  (256  + 64 * (j))
#define XB_XSUB(j)  (1280 + 64 * (j))
#define XB_XGEN(j)  (2304 + 64 * (j))
#define XB_TOP      3328
#define XB_TOPGEN   3392
#define XCD_BAR_WORDS 3456
#define XB_SPIN_CAP (1u << 18)

__device__ __forceinline__ unsigned xb_ld(unsigned* p)              { return __hip_atomic_load(p, __ATOMIC_RELAXED, __HIP_MEMORY_SCOPE_AGENT); }
__device__ __forceinline__ unsigned xb_add(unsigned* p, unsigned v) { return __hip_atomic_fetch_add(p, v, __ATOMIC_RELAXED, __HIP_MEMORY_SCOPE_AGENT); }
__device__ __forceinline__ unsigned xb_xcc_id() { return (unsigned)__builtin_amdgcn_s_getreg((3 << 11) | 20) & 0xFu; }
#define XB_SPIN(cond, bar) do { unsigned _sp = 0; while (cond) { __builtin_amdgcn_s_sleep(1); \
    if ((++_sp & 255u) == 0u) { if (xb_ld(&(bar)[XB_TMO])) break; if (_sp > XB_SPIN_CAP) { atomicAdd(&(bar)[XB_TMO], 1u); break; } } } } while (0)

struct XcdBarrier {
    unsigned* bar; unsigned x;
    volatile LAS unsigned* st;
};

__device__ __forceinline__ XcdBarrier xcd_barrier_post(unsigned* bar, volatile LAS unsigned* st) {
    XcdBarrier b; b.bar = bar; b.x = xb_xcc_id(); b.st = st;
    if (threadIdx.x == 0) (void)xb_add(&bar[XB_XCNT(b.x)], 1u);
    return b;
}
__device__ __forceinline__ void xcd_barrier_complete(unsigned* bar, unsigned x, unsigned& nloc, unsigned& nx) {
    const unsigned G = gridDim.x * gridDim.y * gridDim.z;
    unsigned sum, cnt, mine, sp = 0u;
    for (;;) {
        sum = 0u; cnt = 0u; mine = 0u;
#pragma unroll
        for (unsigned j = 0; j < 16; ++j) { const unsigned c = xb_ld(&bar[XB_XCNT(j)]); sum += c; cnt += (c > 0u) ? 1u : 0u; mine = (j == x) ? c : mine; }
        if (sum == G) break;
        __builtin_amdgcn_s_sleep(1);
        if ((++sp & 255u) == 0u) { if (xb_ld(&bar[XB_TMO])) break; if (sp > XB_SPIN_CAP) { atomicAdd(&bar[XB_TMO], 1u); break; } }
    }
    nloc = mine > 0u ? mine : 1u; nx = cnt > 0u ? cnt : 1u;
}

__device__ __forceinline__ void xcd_barrier(const XcdBarrier& b) {
    asm volatile("s_waitcnt vmcnt(0)" ::: "memory");
    __syncthreads();
    if (threadIdx.x == 0) {
        unsigned* bar = b.bar;
        __builtin_amdgcn_s_waitcnt(0);
        unsigned nloc = b.st[0], nx = b.st[1];
        if (nloc == 0u) { xcd_barrier_complete(bar, b.x, nloc, nx); b.st[0] = nloc; b.st[1] = nx; }
        const unsigned old = xb_add(&bar[XB_XSUB(b.x)], 1u);
        const unsigned gen = old / nloc;
        if (old + 1u == (gen + 1u) * nloc) {
            __builtin_amdgcn_fence(__ATOMIC_RELEASE, "agent");
            asm volatile("s_waitcnt vmcnt(0)" ::: "memory");
            const unsigned og = xb_add(&bar[XB_TOP], 1u);
            const unsigned tg = og / nx;
            if (og + 1u == (tg + 1u) * nx) xb_add(&bar[XB_TOPGEN], 1u);
            else XB_SPIN(xb_ld(&bar[XB_TOPGEN]) == tg, bar);
            __builtin_amdgcn_fence(__ATOMIC_ACQUIRE, "agent");
            xb_add(&bar[XB_XGEN(b.x)], 1u);
            asm volatile("s_waitcnt vmcnt(0)" ::: "memory");
        } else {
            XB_SPIN(xb_ld(&bar[XB_XGEN(b.x)]) == gen, bar);
            __builtin_amdgcn_fence(__ATOMIC_ACQUIRE, "agent");
            asm volatile("s_waitcnt vmcnt(0)" ::: "memory");
        }
    }
    __syncthreads();
}


template <class T> __device__ __forceinline__ T* opq(T* p) { size_t z = 0; asm volatile("" : "+s"(z)); return (T*)((unsigned char*)p + z); }
#define PTRS unsigned char* ws = opq(args.ws); float* out = opq(args.out); const float* xp = args.in[0]; const float* xs = args.in[1]; \
    bf16* WA = (bf16*)(ws + WS_WA); bf16* WB = (bf16*)(ws + WS_WB); bf16* WU = (bf16*)(ws + WS_WU); bf16* WD = (bf16*)(ws + WS_WD); bf16* XN = (bf16*)(ws + WS_XN); bf16* BIG = (bf16*)(ws + WS_BIG); \
    float* ST = (float*)(ws + WS_ST); bf16* HF = (bf16*)out; bf16* HB = HF + (size_t)T_TOK * DMOD; float* SS1 = (float*)(ws + WS_SS); float* SS2 = SS1 + T_TOK; float* SS3 = SS2 + T_TOK; float* SS0 = SS3 + T_TOK; (void)SS0; \
    bf16* W2A = (bf16*)(ws + WS_W2A); bf16* W2B = (bf16*)(ws + WS_W2B); \
    (void)xp; (void)xs; (void)WA; (void)WB; (void)WU; (void)WD; (void)XN; (void)BIG; (void)ST; (void)HF; (void)HB; (void)SS1; (void)SS2; (void)SS3; (void)W2A; (void)W2B
template <int N, int K, int LDA, class Epi>
__device__ __forceinline__ void run_gemm(LAS unsigned char* lds, const bf16* A, const bf16* Bt, const Epi E, int G, int bx) {
    pg8::Gemm g{A, Bt, T_TOK, N, K, LDA}; pg8::StaticOrder S; S.init(T_TOK, N, G, bx);
    pg8::gemm_phase<Epi, pg8::StaticOrder, PG8_ALIGN, PG8_SP2>(lds, g, S, E);
}
struct Args { const float* in[14]; float* out; unsigned char* ws; int ph_lo, ph_hi; };
__global__ void __launch_bounds__(NWAVES * 64, 2) mk_fwd(Args args) {
    extern __shared__ __attribute__((aligned(16))) unsigned char lds_raw[];
    cg::grid_group grid = cg::this_grid();
    LAS unsigned char* lds = (LAS unsigned char*)lds_raw;
    const int tid = threadIdx.x, lane = tid & 63, wave = __builtin_amdgcn_readfirstlane(tid >> 6);
    const int G = gridDim.x, bx = blockIdx.x, vcu = (G % 8 == 0) ? (bx % 8) * (G / 8) + bx / 8 : bx;
    const int gw = bx * NWAVES + wave, NGW = G * NWAVES;
    LAS float* scr = (LAS float*)(lds + wave * 16384);
    volatile LAS unsigned* bst = (volatile LAS unsigned*)(lds + LDS_BYTES - 64);
    if (tid == 0) { bst[0] = 0u; bst[1] = 0u; }
    __syncthreads();
    (void)xcd_barrier_post((unsigned*)args.ws, bst);

    const int lo = args.ph_lo, hi = args.ph_hi;
#define IN(k) (lo <= (k) && (k) < hi)
#define SEAM(k) do { if (IN(k) && IN((k) + 1)) { if (lo < 0) grid.sync(); else { XcdBarrier xb_; xb_.bar = (unsigned*)opq(args.ws); xb_.x = xb_xcc_id(); xb_.st = bst; xcd_barrier(xb_); } } } while (0)
    if (IN(PH_PRE0)) { PTRS;
        convert_weights(args.in[4], DMOD, N_IN, WA, scr, gw, NGW, lane, args.in[2], true);
        for (int i = gw * 64 + lane; i < 4096; i += NGW * 64) { const float ang = (float)(i >> 4) * powf(10000.f, -(float)(2 * (i & 15)) * (1.f / 32.f)); float* tb = (float*)(ws + WS_TAB); tb[i] = cosf(ang); tb[4096 + i] = sinf(ang); }
        for (int m = gw; m < T_TOK; m += NGW) { const float* xr = (m < NPROMPT) ? xp + (size_t)m * DMOD : xs + (size_t)(m - NPROMPT) * DMOD; cvt_row(xr, XN + (size_t)m * DMOD, SS0 + m, lane); }
    }
    SEAM(PH_PRE0);
    if (IN(PH_INPROJ)) { PTRS; run_gemm<3072, DMOD, DMOD, pg8::EpiBf16<0>>(lds, XN, WA, pg8::EpiBf16<0>{BIG, N_IN_PAD, nullptr, 0, 0, 1.f, SS0}, G, bx);
        {
            const bf16* Wg = WA + (size_t)3072 * DMOD;
            const int l15g = lane & 15, qg = lane >> 4;
            for (int blk = gw; blk < T_TOK / 16; blk += NGW) {
                const int r0 = blk * 16;
                f32x4 ga = (f32x4){0.f, 0.f, 0.f, 0.f};
                const bf16* ap = XN + (size_t)(r0 + l15g) * DMOD + 8 * qg;
                const bf16* bp = Wg + (size_t)l15g * DMOD + 8 * qg;
#pragma unroll 8
                for (int sk = 0; sk < 32; ++sk) { const bf16x8 av = *(const bf16x8*)(ap + 32 * sk); const bf16x8 bv = *(const bf16x8*)(bp + 32 * sk); ga = MFMA16(av, bv, ga); }
#pragma unroll
                for (int r = 0; r < 4; ++r) { const int row = r0 + 4 * qg + r;
                    const float rs = 1.0f / sqrtf(SS0[row] * (1.0f / 1024.0f) + 1e-6f);
                    BIG[(size_t)row * N_IN_PAD + 3072 + l15g] = (bf16)(pk2(ga[r] * rs, 0.f) & 0xffffu); }
            }
        }
    }
    SEAM(PH_INPROJ);
#ifndef SKIP_MLSTM
    if (IN(PH_MA)) { PTRS;
        for (int it = vcu; it < 608; it += G) {
            int ci, seg, slice = it & 3;
            if (it < 384) { ci = it / 12; seg = (it >> 2) % 3; } else { const int i2 = it - 384; ci = 32 + i2 / 28; seg = (i2 >> 2) % 7; }
            const bool smp = ci >= 32; const int cc = smp ? ci - 32 : ci;
            const int head = smp ? (cc >> 1) : ((cc >> 1) & 3), dir = cc & 1, rowbase = smp ? NPROMPT : (cc >> 3) * 8192, L = smp ? 16384 : 8192;
            mlstm_item<64, true>(lds, BIG, nullptr, args.in[5], rowbase, L, head, dir, slice, seg * 16, seg * 16 + 16, ST + (size_t)((ci * 8 + seg) * 4 + slice) * ST_SLOT, nullptr, 0);
        }
            {
            int first = 608 - 2 * G; if (first < 0 || first >= G) first = 0;
            if (vcu >= first) { const int gw2 = (vcu - first) * NWAVES + wave, NGW2 = (G - first) * NWAVES;
                convert_weights(args.in[7], DMOD, DMOD, WB, scr, gw2, NGW2, lane);
                convert_weights(args.in[12], DMOD, FF, WU, scr, gw2, NGW2, lane, args.in[3], true); convert_weights(args.in[13], FF, DMOD, WD, scr, gw2, NGW2, lane);
                convert_weights(args.in[8], DMOD, NQKV, W2A, scr, gw2, NGW2, lane, args.in[2] + DMOD, true); convert_weights(args.in[11], DMOD, DMOD, W2B, scr, gw2, NGW2, lane); }
        }
    }
    SEAM(PH_MA);
    if (IN(PH_MB)) { PTRS;
        for (int it = vcu; it < 768; it += G) {
            int ci, seg, slice = it & 3;
            if (it < 512) { ci = it >> 4; seg = (it >> 2) & 3; } else { const int i2 = it - 512; ci = 32 + (i2 >> 5); seg = (i2 >> 2) & 7; }
            const bool smp = ci >= 32; const int cc = smp ? ci - 32 : ci;
            const int head = smp ? (cc >> 1) : ((cc >> 1) & 3), dir = cc & 1, rowbase = smp ? NPROMPT : (cc >> 3) * 8192, L = smp ? 16384 : 8192;
            mlstm_item<64, false>(lds, BIG, dir ? HB : HF, args.in[5], rowbase, L, head, dir, slice, seg * 16, seg * 16 + 16, nullptr, ST + (size_t)((ci * 8) * 4 + slice) * ST_SLOT, seg);
        }
    }
#endif
    SEAM(PH_MB);
#ifndef SKIP_GATE
    if (IN(PH_GATE)) { PTRS;
            const float* gh = args.in[6];
            for (int m = gw; m < T_TOK; m += NGW) {
                v4u f[2], b_[2], o_[2];
#pragma unroll
                for (int h2 = 0; h2 < 2; ++h2) { const int c0 = 512 * h2 + 8 * lane;
                    f[h2] = __builtin_nontemporal_load((const v4u*)(HF + (size_t)m * DMOD + c0)); b_[h2] = __builtin_nontemporal_load((const v4u*)(HB + (size_t)m * DMOD + c0)); o_[h2] = __builtin_nontemporal_load((const v4u*)(BIG + (size_t)m * N_IN_PAD + 2048 + c0)); }
#pragma unroll
                for (int h2 = 0; h2 < 2; ++h2) { const int c0 = 512 * h2 + 8 * lane;
                    float hs[8], og[8];
#pragma unroll
                    for (int i = 0; i < 4; ++i) { hs[2 * i] = bflo(f[h2][i]) + bflo(b_[h2][i]); hs[2 * i + 1] = bfhi(f[h2][i]) + bfhi(b_[h2][i]); og[2 * i] = bflo(o_[h2][i]); og[2 * i + 1] = bfhi(o_[h2][i]); }
                    float s = 0.f;
#pragma unroll
                    for (int i = 0; i < 8; ++i) s += hs[i] * hs[i];
                    s += __shfl_xor(s, 1); s += __shfl_xor(s, 2); s += __shfl_xor(s, 4); s += __shfl_xor(s, 8); s += __shfl_xor(s, 16);
                    const float r = 1.0f / sqrtf(s * (1.f / 256.f) + EPS);
                    const f32x4 g0 = *(const f32x4*)(gh + c0), g1 = *(const f32x4*)(gh + c0 + 4);
                    float y[8];
#pragma unroll
                    for (int i = 0; i < 4; ++i) { y[i] = hs[i] * r * g0[i] / (1.0f + fexp(-og[i])); y[4 + i] = hs[4 + i] * r * g1[i] / (1.0f + fexp(-og[4 + i])); }
                    v4u yo; yo.x = pk2(y[0], y[1]); yo.y = pk2(y[2], y[3]); yo.z = pk2(y[4], y[5]); yo.w = pk2(y[6], y[7]);
                    *(v4u*)(BIG + (size_t)m * N_IN_PAD + c0) = yo;
                }
            }
    }
#endif
    SEAM(PH_GATE);
    if (IN(PH_OUTPROJ)) { PTRS; run_gemm<DMOD, DMOD, N_IN_PAD, EpiRes<1>>(lds, BIG, WB, EpiRes<1>{nullptr, nullptr, 0, nullptr, DMOD, XN, SS1}, G, bx); }
    SEAM(PH_OUTPROJ);
    if (IN(PH_UP0)) { PTRS; run_gemm<FF, DMOD, DMOD, pg8::EpiBf16<2>>(lds, XN, WU, pg8::EpiBf16<2>{BIG, FF, nullptr, 0, 0, 1.f, nullptr}, G, bx); }
    SEAM(PH_UP0);
    if (IN(PH_DOWN0)) { PTRS; run_gemm<DMOD, FF, FF, EpiRes<1>>(lds, BIG, WD, EpiRes<1>{nullptr, SS1, 0, nullptr, DMOD, XN, SS2}, G, bx); }
    SEAM(PH_DOWN0);
    if (IN(PH_QKV)) { PTRS; run_gemm<NQKV, DMOD, DMOD, EpiQKV>(lds, XN, W2A, EpiQKV{BIG, SS2, args.in[9], args.in[10], (const float*)(ws + WS_TAB)}, G, bx);
        {
            const int nun = (T_TOK / 256) * (NQKV / 256); int first = nun % G; if (first == 0) first = 0;
            const int nconv = G - first;
            if (bx >= first) { const int gw2 = (bx - first) * NWAVES + wave, NGW2 = nconv * NWAVES;
                convert_weights(args.in[12] + (size_t)DMOD * FF, DMOD, FF, WU, scr, gw2, NGW2, lane, args.in[3] + DMOD, true); convert_weights(args.in[13] + (size_t)DMOD * FF, FF, DMOD, WD, scr, gw2, NGW2, lane); }
        }
    }
    SEAM(PH_QKV);
#ifndef SKIP_ATTN
    if (IN(PH_ATTN)) { PTRS;
            const attn_body::bf16* Qp = (const attn_body::bf16*)BIG; const attn_body::bf16* Kp = Qp + 1024; const attn_body::bf16* Vp = Qp + 1280; attn_body::bf16* Op = (attn_body::bf16*)BIG;
            float gqm = fabsf(args.in[9][lane]), gkm = fabsf(args.in[10][lane]);
#pragma unroll
            for (int o = 1; o < 64; o <<= 1) { gqm = fmaxf(gqm, __shfl_xor(gqm, o)); gkm = fmaxf(gkm, __shfl_xor(gkm, o)); }
            const float mref = 8.0f * gqm * gkm * 1.4426950408889634f * 1.03f + 0.25f;
            if (G == 256) {
                if (vcu < 128) {
                    const int seq = vcu >> 5, cl = vcu & 31;
                    for (int i = 0; i < 16; ++i) attn_body::attn_unit<8>(mref, (long)seq * 8192, 8192, 4 * (i >> 2) + (cl & 3), 4 * (cl >> 2) + (i & 3), Qp, Kp, Vp, Op, (char*)lds_raw); }
                else { const int v = vcu - 128, head = v >> 3, qb0 = (v & 7) * 8;
                    for (int i = 0; i < 8; ++i) attn_body::attn_unit<8>(mref, (long)NPROMPT, 16384, head, qb0 + i, Qp, Kp, Vp, Op, (char*)lds_raw); }
            } else {
                for (int u = vcu; u < 3072; u += G) {
                    if (u < 2048) attn_body::attn_unit<8>(mref, (long)(u >> 9) * 8192, 8192, (u >> 5) & 15, u & 31, Qp, Kp, Vp, Op, (char*)lds_raw);
                    else { const int u2 = u - 2048; attn_body::attn_unit<8>(mref, (long)NPROMPT, 16384, u2 >> 6, u2 & 63, Qp, Kp, Vp, Op, (char*)lds_raw); }
                }
            }
    }
#endif
    SEAM(PH_ATTN);
    if (IN(PH_OPROJ)) { PTRS; run_gemm<DMOD, DMOD, NQKV, EpiRes<1>>(lds, BIG, W2B, EpiRes<1>{nullptr, nullptr, 0, nullptr, DMOD, XN, SS3}, G, bx); }
    SEAM(PH_OPROJ);
    if (IN(PH_UP1)) { PTRS; run_gemm<FF, DMOD, DMOD, pg8::EpiBf16<2>>(lds, XN, WU, pg8::EpiBf16<2>{BIG, FF, nullptr, 0, 0, 1.f, nullptr}, G, bx); }
    SEAM(PH_UP1);
    if (IN(PH_DOWN1)) { PTRS; run_gemm<DMOD, FF, FF, EpiRes<2>>(lds, BIG, WD, EpiRes<2>{nullptr, SS3, 0, out, DMOD, XN, nullptr}, G, bx); }
#undef IN
#undef SEAM
}

extern "C" void kernel_launch(void* const* d_in, const int* in_sizes, int n_in, void* d_out, int out_size, void* d_ws, size_t ws_size, hipStream_t stream) {
    static int grid = 0;
    if (grid == 0) {
        if (n_in != 14 || out_size != T_TOK * DMOD || ws_size < WS_END) { fprintf(stderr, "kernel_launch: unexpected shapes: n_in %d out %d ws %zu (need %zu)\n", n_in, out_size, ws_size, (size_t)WS_END); grid = -1; return; }
        int dev = 0, cus = 0, per_cu = 0;
        if (hipGetDevice(&dev) != hipSuccess || hipDeviceGetAttribute(&cus, hipDeviceAttributeMultiprocessorCount, dev) != hipSuccess) { grid = -1; return; }
        if (hipFuncSetAttribute((const void*)mk_fwd, hipFuncAttributeMaxDynamicSharedMemorySize, LDS_BYTES) != hipSuccess) { fprintf(stderr, "kernel_launch: hipFuncSetAttribute failed\n"); grid = -1; return; }
        if (hipOccupancyMaxActiveBlocksPerMultiprocessor(&per_cu, (const void*)mk_fwd, NWAVES * 64, LDS_BYTES) != hipSuccess || per_cu < 1) per_cu = 1;
        (void)hipGetLastError();
        grid = cus * per_cu;
    }
    if (grid < 0) return;
    if (hipMemsetAsync(d_ws, 0, CTL_ZERO_BYTES, stream) != hipSuccess) { fprintf(stderr, "kernel_launch: memset of the barrier words failed\n"); return; }
    Args a{};
    for (int i = 0; i < 14; ++i) a.in[i] = (const float*)d_in[i];
    a.out = (float*)d_out; a.ws = (unsigned char*)d_ws;
#if MK_N_LAUNCHES == 1
    a.ph_lo = 0; a.ph_hi = NPHASE;
    void* kargs[] = {&a};
    hipError_t e = hipLaunchCooperativeKernel((const void*)mk_fwd, dim3(grid), dim3(NWAVES * 64), kargs, LDS_BYTES, stream);
    if (e != hipSuccess) fprintf(stderr, "cooperative launch failed: %s (grid %d)\n", hipGetErrorString(e), grid);
#else
    for (int ph = 0; ph < NPHASE; ++ph) {
        a.ph_lo = ph; a.ph_hi = ph + 1;
        hipLaunchKernelGGL(mk_fwd, dim3(grid), dim3(NWAVES * 64), LDS_BYTES, stream, a);
#ifdef PROBE_MASK
        if ((PROBE_MASK >> ph) & 1) hipLaunchKernelGGL(mk_fwd, dim3(grid), dim3(NWAVES * 64), LDS_BYTES, stream, a);
#endif
    }
#endif
}
```
